# Optimizing an MI355X kernel written in HIP

```python
import jax, jax.numpy as jnp
from jax import lax
import numpy as np

D_MODEL = 1024
BATCH = 8
SEQ = 4096
DEPTH = 2

MEM_LEN = 256
HEAD_DIM = 64
NSA_HEADS = 8
NSA_KV_HEADS = 2
NSA_GROUP = NSA_HEADS // NSA_KV_HEADS
CMP_BLOCK = 32
CMP_STRIDE = 16
CMP_HIDDEN = 256
SLC_BLOCK = 64
SLC_TOP = 16
WINDOW = 512
NSA_QBLOCK = 64
SLC_FORCED_SCORE = 1e4
SGU_GROUPS = 4
SGU_CH = 128
SGU_CHUNK = 128
HGRN_HEADS = 4
HGRN_DK = 128
HGRN_DV = 128
HGRN_CHUNK = 64
CONV_CH = 512
CONV_WIDTH = 3
XATTN_HEADS = 4
XATTN_DIM = D_MODEL // XATTN_HEADS
N_EXPERTS = 32
TOP_K = 4
D_EXPERT = D_MODEL
SWIGLU_LIMIT = 7.0
SWIGLU_ALPHA = 1.702
MOE_BLOCK = 128

ROPE_THETA = 10000.0
LN_EPS = 1e-5
RMS_EPS = 1e-6
NEG_INF = -1e30
DEEPNORM_ALPHA = (2 * DEPTH) ** 0.25
DEEPNORM_BETA = (8 * DEPTH) ** -0.25

N_EVEN = (DEPTH + 1) // 2
N_ODD = DEPTH // 2
NSA_Q = NSA_HEADS * HEAD_DIM
NSA_KV = 3 * 2 * NSA_KV_HEADS * HEAD_DIM
NSA_GATES = 3 * NSA_HEADS
SGU_W = SGU_GROUPS * SGU_CH
EVEN_IN = NSA_Q + NSA_KV + NSA_GATES + 2 * SGU_W
EVEN_OUT = NSA_Q + SGU_W
HGRN_W = HGRN_HEADS * HGRN_DK
ODD_IN = 4 * HGRN_W + 3 * CONV_CH
ODD_OUT = HGRN_W + CONV_CH

kernel_name = "hybrid_nsa_gmlp_hgrn2_conv_moe_deepnorm"


def layer_norm(x, g, b):
    xf = x.astype(jnp.float32)
    mu = jnp.mean(xf, axis=-1, keepdims=True)
    var = jnp.mean(jnp.square(xf - mu), axis=-1, keepdims=True)
    return ((xf - mu) * lax.rsqrt(var + LN_EPS) * g + b).astype(x.dtype)


def rope_tables(positions):
    inv = 1.0 / (ROPE_THETA ** (jnp.arange(0, HEAD_DIM, 2, dtype=jnp.float32) / HEAD_DIM))
    ang = positions.astype(jnp.float32)[..., None] * inv
    return jnp.cos(ang)[:, :, None, :], jnp.sin(ang)[:, :, None, :]


def apply_rope(x, cos, sin):
    x1, x2 = jnp.split(x.astype(jnp.float32), 2, axis=-1)
    return jnp.concatenate([x1 * cos - x2 * sin, x2 * cos + x1 * sin], axis=-1).astype(x.dtype)


def masked_softmax(s, mask):
    s = jnp.where(mask, s.astype(jnp.float32), NEG_INF)
    return jax.nn.softmax(s, axis=-1) * mask


def cmp_to_slc_matrix(seq):
    nc = (seq - CMP_BLOCK) // CMP_STRIDE + 1
    ns = seq // SLC_BLOCK
    cs = np.arange(nc)[:, None] * CMP_STRIDE
    ss = np.arange(ns)[None, :] * SLC_BLOCK
    ov = np.clip(np.minimum(cs + CMP_BLOCK, ss + SLC_BLOCK) - np.maximum(cs, ss), 0, None)
    return jnp.asarray(ov / CMP_BLOCK, dtype=jnp.float32)


def nsa_mixer(q, kv, gates, cos, sin, cmp_pos, cmp_w1, cmp_w2):
    Bsz, S, _ = q.shape
    G, Hg, hd, QB = NSA_KV_HEADS, NSA_GROUP, HEAD_DIM, NSA_QBLOCK
    dt = q.dtype
    q = q.reshape(Bsz, S, NSA_HEADS, hd)
    q_rot = apply_rope(q, cos, sin)
    kv = kv.reshape(Bsz, S, 6, G, hd)
    k_cmp, v_cmp, k_slc, v_slc, k_win, v_win = [kv[:, :, i] for i in range(6)]
    k_slc = apply_rope(k_slc, cos, sin)
    k_win = apply_rope(k_win, cos, sin)

    nc = (S - CMP_BLOCK) // CMP_STRIDE + 1
    idx = np.arange(nc)[:, None] * CMP_STRIDE + np.arange(CMP_BLOCK)[None, :]

    def compress(t, pos, w1, w2):
        blocks = t[:, idx] + pos[None, None, :, None, :]
        blocks = blocks.transpose(0, 3, 1, 2, 4).reshape(Bsz, G, nc, CMP_BLOCK * hd)
        return jax.nn.gelu(blocks @ w1) @ w2

    kc = compress(k_cmp, cmp_pos[0], cmp_w1[0], cmp_w2[0])
    vc = compress(v_cmp, cmp_pos[1], cmp_w1[1], cmp_w2[1])
    cmp_end = np.arange(nc) * CMP_STRIDE + CMP_BLOCK - 1

    n_slc = S // SLC_BLOCK
    n_top = min(SLC_TOP, n_slc)
    ks_blk = k_slc.reshape(Bsz, n_slc, SLC_BLOCK, G, hd).transpose(0, 3, 1, 2, 4)
    vs_blk = v_slc.reshape(Bsz, n_slc, SLC_BLOCK, G, hd).transpose(0, 3, 1, 2, 4)
    m_cmp = cmp_to_slc_matrix(S)
    slc_ids = jnp.arange(n_slc)
    b_ix = jnp.arange(Bsz)[:, None, None, None]
    g_ix = jnp.arange(G)[None, None, :, None]

    kw_pad = jnp.pad(k_win, ((0, 0), (WINDOW, 0), (0, 0), (0, 0)))
    vw_pad = jnp.pad(v_win, ((0, 0), (WINDOW, 0), (0, 0), (0, 0)))

    gates = jax.nn.sigmoid(gates.astype(jnp.float32)).reshape(Bsz, S, G, Hg, 3)
    scale = hd ** -0.5

    def block(qi):
        s0 = qi * QB
        t = s0 + jnp.arange(QB)
        qb = lax.dynamic_slice_in_dim(q, s0, QB, axis=1).reshape(Bsz, QB, G, Hg, hd)
        qr = lax.dynamic_slice_in_dim(q_rot, s0, QB, axis=1).reshape(Bsz, QB, G, Hg, hd)
        gb = lax.dynamic_slice_in_dim(gates, s0, QB, axis=1)

        s = jnp.einsum('bqghd,bgnd->bqghn', qb, kc) * scale
        mask = (cmp_end[None, :] <= t[:, None])[None, :, None, None, :]
        p_cmp = masked_softmax(s, mask)
        o_cmp = jnp.einsum('bqghn,bgnd->bqghd', p_cmp.astype(dt), vc)

        imp = jnp.einsum('bqgn,nj->bqgj', p_cmp.sum(axis=3), m_cmp)
        cur = (t // SLC_BLOCK)[:, None]
        forced = ((slc_ids == 0) | (slc_ids == cur) | (slc_ids == cur - 1))[None, :, None, :]
        valid = (slc_ids <= cur)[None, :, None, :]
        score = jnp.where(forced, SLC_FORCED_SCORE, jnp.where(valid, imp, -1.0))
        _, sel = lax.top_k(score, n_top)
        k_sel = ks_blk[b_ix, g_ix, sel]
        v_sel = vs_blk[b_ix, g_ix, sel].reshape(Bsz, QB, G, n_top * SLC_BLOCK, hd)
        tok = sel[..., None] * SLC_BLOCK + jnp.arange(SLC_BLOCK)
        m_slc = (tok <= t[None, :, None, None, None]).reshape(Bsz, QB, G, 1, n_top * SLC_BLOCK)
        s = jnp.einsum('bqghd,bqgnkd->bqghnk', qr, k_sel).reshape(Bsz, QB, G, Hg, n_top * SLC_BLOCK) * scale
        p = masked_softmax(s, m_slc)
        o_slc = jnp.einsum('bqghm,bqgmd->bqghd', p.astype(dt), v_sel)

        kw = lax.dynamic_slice_in_dim(kw_pad, s0, QB + WINDOW, axis=1)
        vw = lax.dynamic_slice_in_dim(vw_pad, s0, QB + WINDOW, axis=1)
        kpos = s0 - WINDOW + jnp.arange(QB + WINDOW)
        dist = t[:, None] - kpos[None, :]
        m_win = (kpos[None, :] >= 0) & (dist >= 0) & (dist < WINDOW)
        s = jnp.einsum('bqghd,bkgd->bqghk', qr, kw) * scale
        p = masked_softmax(s, m_win[None, :, None, None, :])
        o_win = jnp.einsum('bqghk,bkgd->bqghd', p.astype(dt), vw)

        o = gb[..., 0:1] * o_cmp + gb[..., 1:2] * o_slc + gb[..., 2:3] * o_win
        return o.astype(dt).reshape(Bsz, QB, NSA_Q)

    out = lax.map(block, jnp.arange(S // QB))
    return out.transpose(1, 0, 2, 3).reshape(Bsz, S, NSA_Q)


def sgu_mixer(u, v, ln_g, ln_b, w_s, b_s):
    Bsz, S, _ = u.shape
    u = jax.nn.gelu(u)
    v = jax.nn.gelu(v).reshape(Bsz, S // SGU_CHUNK, SGU_CHUNK, SGU_GROUPS, SGU_CH)
    v = layer_norm(v, ln_g, ln_b)
    causal = jnp.tril(jnp.ones((SGU_CHUNK, SGU_CHUNK), dtype=w_s.dtype))
    mix = jnp.einsum('gts,bnsgc->bntgc', w_s * causal, v) + b_s.T[:, :, None]
    return u * mix.reshape(Bsz, S, SGU_W)


def hgrn2_mixer(q, f_raw, i, g, lb, norm_g):
    Bsz, S, _ = q.shape
    H, dk, dv, C = HGRN_HEADS, HGRN_DK, HGRN_DV, HGRN_CHUNK
    z = f_raw.astype(jnp.float32)
    log_f = jnp.logaddexp(jnp.log(lb), jnp.log1p(-lb) + jax.nn.log_sigmoid(z))
    k = (1.0 - lb) * jax.nn.sigmoid(-z)
    n = S // C

    def chunks(t, d):
        return t.astype(jnp.float32).reshape(Bsz, n, C, H, d).transpose(1, 0, 3, 2, 4)

    qc, kc, vc, lc = chunks(q, dk), chunks(k, dk), chunks(i, dv), chunks(log_f, dk)
    causal = jnp.tril(jnp.ones((C, C), dtype=bool))[None, None, :, :, None]

    def step(state, inp):
        qt, kt, vt, lt = inp
        b = jnp.cumsum(lt, axis=2)
        o_inter = jnp.einsum('bhtk,bhkv->bhtv', qt * jnp.exp(b), state)
        decay = jnp.exp(jnp.where(causal, b[:, :, :, None, :] - b[:, :, None, :, :], NEG_INF))
        attn = jnp.einsum('bhtk,bhsk,bhtsk->bhts', qt, kt, decay)
        o = o_inter + jnp.einsum('bhts,bhsv->bhtv', attn, vt)
        b_last = b[:, :, -1:, :]
        new_state = (jnp.exp(b_last[:, :, 0, :])[..., None] * state
                     + jnp.einsum('bhsk,bhsv->bhkv', kt * jnp.exp(b_last - b), vt))
        return new_state, o

    state0 = jnp.zeros((Bsz, H, dk, dv), jnp.float32)
    _, o = lax.scan(step, state0, (qc, kc, vc, lc))
    o = o.transpose(1, 0, 3, 2, 4).reshape(Bsz, S, H, dv)
    o = o * lax.rsqrt(jnp.mean(jnp.square(o), axis=-1, keepdims=True) + RMS_EPS) * norm_g
    return (o.reshape(Bsz, S, H * dv) * jax.nn.silu(g.astype(jnp.float32))).astype(q.dtype)


def short_conv_mixer(h, b_gate, c_gate, conv_w, conv_b):
    z = c_gate * h
    y = lax.conv_general_dilated(z, conv_w[:, None, :].astype(z.dtype), window_strides=(1,),
                                 padding=((CONV_WIDTH - 1, 0),),
                                 dimension_numbers=('NWC', 'WIO', 'NWC'),
                                 feature_group_count=CONV_CH) + conv_b
    return b_gate * y


def memory_cross_attention(x, mem, w_q, w_kv, w_o):
    Bsz, S, _ = x.shape
    q = (x @ w_q).reshape(Bsz, S, XATTN_HEADS, XATTN_DIM)
    kv = (mem @ w_kv).reshape(Bsz, mem.shape[1], 2, XATTN_HEADS, XATTN_DIM)
    s = jnp.einsum('bqhd,bkhd->bhqk', q, kv[:, :, 0]).astype(jnp.float32) * XATTN_DIM ** -0.5
    p = jax.nn.softmax(s, axis=-1).astype(x.dtype)
    o = jnp.einsum('bhqk,bkhd->bqhd', p, kv[:, :, 1]).reshape(Bsz, S, XATTN_HEADS * XATTN_DIM)
    return o @ w_o


def moe_ffn(x, w_router, b_router, w_gu, b_gu, w_dn, b_dn):
    Bsz, S, D = x.shape
    xt = x.reshape(-1, D)
    T = xt.shape[0]
    logits = (xt @ w_router).astype(jnp.float32) + b_router
    top_v, top_e = lax.top_k(logits, TOP_K)
    gate = jax.nn.softmax(top_v, axis=-1)
    TK = T * TOP_K
    e_flat = top_e.reshape(-1)
    tok_flat = jnp.arange(TK, dtype=jnp.int32) // TOP_K
    g_flat = gate.reshape(-1)
    order = jnp.argsort(e_flat)
    e_s, tok_s, g_s = e_flat[order], tok_flat[order], g_flat[order]
    counts = jnp.bincount(e_flat, length=N_EXPERTS)
    start = jnp.cumsum(counts) - counts
    padded = (counts + MOE_BLOCK - 1) // MOE_BLOCK * MOE_BLOCK
    pend = jnp.cumsum(padded)
    pstart = pend - padded
    dest = pstart[e_s] + (jnp.arange(TK) - start[e_s])
    R = (-(-TK // MOE_BLOCK) + N_EXPERTS) * MOE_BLOCK
    nb = R // MOE_BLOCK
    row_tok = jnp.zeros((R,), jnp.int32).at[dest].set(tok_s)
    row_gate = jnp.zeros((R,), jnp.float32).at[dest].set(g_s)
    blk_e = jnp.minimum(jnp.searchsorted(pend, jnp.arange(nb) * MOE_BLOCK, side='right'), N_EXPERTS - 1)

    def expert_block(args):
        e, toks = args
        h = xt[toks] @ w_gu[e] + b_gu[e]
        h_gate = jnp.minimum(h[:, :D_EXPERT], SWIGLU_LIMIT)
        h_up = jnp.clip(h[:, D_EXPERT:], -SWIGLU_LIMIT, SWIGLU_LIMIT)
        act = (h_up + 1.0) * (h_gate * jax.nn.sigmoid(h_gate * SWIGLU_ALPHA))
        return act @ w_dn[e] + b_dn[e]

    y = lax.map(expert_block, (blk_e, row_tok.reshape(nb, MOE_BLOCK))).reshape(R, D)
    out = jnp.zeros((T, D), jnp.float32).at[row_tok].add(y.astype(jnp.float32) * row_gate[:, None])
    return out.astype(x.dtype).reshape(Bsz, S, D)


def setup_inputs(seed: int = 0) -> dict:
    key = jax.random.key(seed)
    ks = jax.random.split(key, 32)
    f32 = jnp.float32

    def nrm(k, shape, fan_in, scale=1.0):
        return jax.random.normal(k, shape, f32) * (fan_in ** -0.5 * scale)

    def small(k, shape):
        return 0.01 * jax.random.normal(k, shape, f32)

    offset = jax.random.randint(ks[2], (BATCH, 1), 0, 2048, dtype=jnp.int32)
    positions = offset + jnp.arange(SEQ, dtype=jnp.int32)[None, :]
    return {
        "x": jax.random.normal(ks[0], (BATCH, SEQ, D_MODEL), f32),
        "mem": jax.random.normal(ks[1], (BATCH, MEM_LEN, D_MODEL), f32),
        "positions": positions,
        "w_in_even": nrm(ks[3], (N_EVEN, D_MODEL, EVEN_IN), D_MODEL),
        "nsa_cmp_pos": 0.1 * jax.random.normal(ks[4], (N_EVEN, 2, CMP_BLOCK, HEAD_DIM), f32),
        "nsa_cmp_w1": nrm(ks[5], (N_EVEN, 2, CMP_BLOCK * HEAD_DIM, CMP_HIDDEN), CMP_BLOCK * HEAD_DIM),
        "nsa_cmp_w2": nrm(ks[6], (N_EVEN, 2, CMP_HIDDEN, HEAD_DIM), CMP_HIDDEN),
        "sgu_ln_g": 1.0 + small(ks[7], (N_EVEN, SGU_GROUPS, SGU_CH)),
        "sgu_ln_b": small(ks[8], (N_EVEN, SGU_GROUPS, SGU_CH)),
        "sgu_w": nrm(ks[9], (N_EVEN, SGU_GROUPS, SGU_CHUNK, SGU_CHUNK), SGU_CHUNK),
        "sgu_b": 1.0 + small(ks[10], (N_EVEN, SGU_GROUPS, SGU_CHUNK)),
        "w_out_even": nrm(ks[11], (N_EVEN, EVEN_OUT, D_MODEL), EVEN_OUT, DEEPNORM_BETA),
        "w_in_odd": nrm(ks[12], (N_ODD, D_MODEL, ODD_IN), D_MODEL),
        "hgrn_lb_logits": 0.1 * jax.random.normal(ks[13], (DEPTH, HGRN_W), f32),
        "hgrn_norm_g": 1.0 + small(ks[14], (N_ODD, HGRN_HEADS, HGRN_DV)),
        "conv_w": nrm(ks[15], (N_ODD, CONV_WIDTH, CONV_CH), CONV_WIDTH),
        "conv_b": small(ks[16], (N_ODD, CONV_CH)),
        "w_out_odd": nrm(ks[17], (N_ODD, ODD_OUT, D_MODEL), ODD_OUT, DEEPNORM_BETA),
        "xattn_w_q": nrm(ks[18], (DEPTH, D_MODEL, XATTN_HEADS * XATTN_DIM), D_MODEL),
        "xattn_w_kv": nrm(ks[19], (DEPTH, D_MODEL, 2 * XATTN_HEADS * XATTN_DIM), D_MODEL),
        "xattn_w_o": nrm(ks[20], (DEPTH, XATTN_HEADS * XATTN_DIM, D_MODEL), XATTN_HEADS * XATTN_DIM, DEEPNORM_BETA),
        "ln_g": 1.0 + small(ks[21], (DEPTH, 3, D_MODEL)),
        "ln_b": small(ks[22], (DEPTH, 3, D_MODEL)),
        "router_w": nrm(ks[23], (DEPTH, D_MODEL, N_EXPERTS), D_MODEL),
        "router_b": small(ks[24], (DEPTH, N_EXPERTS)),
        "expert_w_gu": nrm(ks[25], (DEPTH, N_EXPERTS, D_MODEL, 2 * D_EXPERT), D_MODEL),
        "expert_b_gu": small(ks[26], (DEPTH, N_EXPERTS, 2 * D_EXPERT)),
        "expert_w_dn": nrm(ks[27], (DEPTH, N_EXPERTS, D_EXPERT, D_MODEL), D_EXPERT, DEEPNORM_BETA),
        "expert_b_dn": small(ks[28], (DEPTH, N_EXPERTS, D_MODEL)),
    }


def reference(x, mem, positions, w_in_even, nsa_cmp_pos, nsa_cmp_w1, nsa_cmp_w2, sgu_ln_g, sgu_ln_b,
              sgu_w, sgu_b, w_out_even, w_in_odd, hgrn_lb_logits, hgrn_norm_g, conv_w, conv_b,
              w_out_odd, xattn_w_q, xattn_w_kv, xattn_w_o, ln_g, ln_b, router_w, router_b,
              expert_w_gu, expert_b_gu, expert_w_dn, expert_b_dn):
    cos, sin = rope_tables(positions)
    lb_weights = jax.nn.softmax(hgrn_lb_logits.astype(jnp.float32), axis=0)
    even_split = [NSA_Q, NSA_Q + NSA_KV, NSA_Q + NSA_KV + NSA_GATES, NSA_Q + NSA_KV + NSA_GATES + SGU_W]
    for layer in range(DEPTH):
        j = layer // 2
        if layer % 2 == 0:
            proj = x @ w_in_even[j]
            q, kv, gts, u, v = jnp.split(proj, even_split, axis=-1)
            o_a = nsa_mixer(q, kv, gts, cos, sin, nsa_cmp_pos[j], nsa_cmp_w1[j], nsa_cmp_w2[j])
            o_b = sgu_mixer(u, v, sgu_ln_g[j], sgu_ln_b[j], sgu_w[j], sgu_b[j])
            mix = jnp.concatenate([o_a, o_b], axis=-1) @ w_out_even[j]
        else:
            proj = x @ w_in_odd[j]
            q, f_raw, i_in, g_out, h, b_gate, c_gate = jnp.split(proj, 7, axis=-1)
            lb = jnp.sum(lb_weights[1:layer + 1], axis=0)
            o_c = hgrn2_mixer(q, f_raw, i_in, g_out, lb, hgrn_norm_g[j])
            o_d = short_conv_mixer(h, b_gate, c_gate, conv_w[j], conv_b[j])
            mix = jnp.concatenate([o_c, o_d], axis=-1) @ w_out_odd[j]
        x = layer_norm(DEEPNORM_ALPHA * x + mix, ln_g[layer, 0], ln_b[layer, 0])
        xa = memory_cross_attention(x, mem, xattn_w_q[layer], xattn_w_kv[layer], xattn_w_o[layer])
        x = layer_norm(DEEPNORM_ALPHA * x + xa, ln_g[layer, 1], ln_b[layer, 1])
        ff = moe_ffn(x, router_w[layer], router_b[layer], expert_w_gu[layer], expert_b_gu[layer],
                     expert_w_dn[layer], expert_b_dn[layer])
        x = layer_norm(DEEPNORM_ALPHA * x + ff, ln_g[layer, 2], ln_b[layer, 2])
    return x
```

```cpp
#include <hip/hip_runtime.h>
#include <cstdio>
#include <cstdint>

#ifndef ONE_LAUNCH
#define ONE_LAUNCH 0
#endif

#define LAS __attribute__((address_space(3)))
#define DI __device__ __forceinline__
typedef unsigned short bf16;
typedef short bf16x8 __attribute__((ext_vector_type(8)));
typedef float f32x4 __attribute__((ext_vector_type(4)));
typedef float f32x2 __attribute__((ext_vector_type(2)));
typedef unsigned u32x4 __attribute__((ext_vector_type(4)));
typedef unsigned u32x2 __attribute__((ext_vector_type(2)));
typedef unsigned long long u64;

constexpr int NB = 8, SEQ = 4096, T = NB * SEQ, DM = 1024;
constexpr int EVEN_IN = 2328, EVEN_PAD = 2560, ODD_IN = 3584;
constexpr int NEXP = 32, TOPK = 4;
constexpr int XG_ROWS = T * TOPK + NEXP * 256;
constexpr float ALPHA = 1.41421356237f;
constexpr int NWAVES = 8, NTHREADS = 512;

constexpr size_t MiB = 1u << 20;
constexpr size_t WS_CTL = 0, CTL_BYTES = 1 * MiB;
constexpr size_t WS_WEVEN = 1 * MiB, WS_WODD = 6 * MiB, WS_WOUTE = 13 * MiB, WS_WOUTO = 15 * MiB, WS_WXQ = 17 * MiB, WS_WXKV = 21 * MiB, WS_WXO = 29 * MiB;
constexpr size_t WS_WGU = 33 * MiB, WS_WDN = 289 * MiB;
constexpr size_t WS_XB = 417 * MiB, WS_MEMB = 481 * MiB, WS_ROPEC = 485 * MiB, WS_ROPES = 489 * MiB;
constexpr size_t WS_MIXIN = 493 * MiB, WS_YBUF = 557 * MiB, WS_XA = 685 * MiB, WS_XBF = 813 * MiB;
constexpr size_t WS_XKV = 941 * MiB, WS_XQ = 957 * MiB, WS_XO = 1021 * MiB, WS_MOETAB = 1085 * MiB, WS_R1 = 1089 * MiB, WS_END = 1905 * MiB;
constexpr size_t R_PROJ = WS_R1, R_QN = WS_R1 + 224 * MiB, R_QR = WS_R1 + 256 * MiB, R_KCMP = WS_R1 + 288 * MiB, R_VCMP = WS_R1 + 297 * MiB;
constexpr size_t R_KSLC = WS_R1 + 306 * MiB, R_VSLC = WS_R1 + 314 * MiB, R_KWIN = WS_R1 + 322 * MiB, R_VWIN = WS_R1 + 330 * MiB;
constexpr size_t R_GATES = WS_R1 + 338 * MiB, R_UG = WS_R1 + 341 * MiB, R_VN = WS_R1 + 373 * MiB, R_H1 = WS_R1 + 405 * MiB;
constexpr size_t R_KC = WS_R1 + 413 * MiB, R_VC = WS_R1 + 414 * MiB, R_SELM = WS_R1 + 415 * MiB, R_OCMP = WS_R1 + 416 * MiB;
constexpr size_t R_FBUF = WS_R1 + 480 * MiB, R_ORAW = WS_R1 + 544 * MiB;
constexpr size_t R_XG = WS_R1, R_ACT = WS_R1 + 272 * MiB, R_YEXP = WS_R1 + 544 * MiB;
constexpr size_t MT_TOKE = 0, MT_TOKG = 512 * 1024, MT_TOKSLOT = 1024 * 1024, MT_HIST = 1536 * 1024, MT_TILEE = 1536 * 1024 + 64 * 1024;
constexpr int CW_BAR = 4096;

constexpr int STAGE_BYTES_LDS = 131072, LDSCTL_OFF = 131072, LDS_BYTES = 147456;

DI float bf2f(bf16 v) { return __uint_as_float(((unsigned)v) << 16); }
DI unsigned f2bf(float f) { unsigned u = __float_as_uint(f); return (u + 0x7fffu + ((u >> 16) & 1u)) >> 16; }
DI unsigned pk2(float lo, float hi) { return f2bf(lo) | (f2bf(hi) << 16); }
DI float wave_sum(float v) {
#pragma unroll
    for (int o = 1; o < 64; o <<= 1) v += __shfl_xor(v, o);
    return v;
}
DI float wave_max(float v) {
#pragma unroll
    for (int o = 1; o < 64; o <<= 1) v = fmaxf(v, __shfl_xor(v, o));
    return v;
}
DI float rdlane(float x, int i) { return __builtin_bit_cast(float, __builtin_amdgcn_readlane(__builtin_bit_cast(int, x), i)); }
DI float gelu_tanh(float x) { const float u = 0.7978845608028654f * (x + 0.044715f * x * x * x); return 0.5f * x * (1.0f + tanhf(u)); }
DI float sigmoidf(float x) { return 1.0f / (1.0f + __expf(-x)); }
#define LDS_WAIT() asm volatile("s_waitcnt lgkmcnt(0)" ::: "memory")

#define XB_TMO      128
#define XB_XCNT(j)  (256  + 64 * (j))
#define XB_XSUB(j)  (1280 + 64 * (j))
#define XB_XGEN(j)  (2304 + 64 * (j))
#define XB_TOP      3328
#define XB_TOPGEN   3392
#define XCD_BAR_WORDS 3456
#define XB_SPIN_CAP (1u << 18)
__device__ __forceinline__ unsigned xb_ld(unsigned* p)              { return __hip_atomic_load(p, __ATOMIC_RELAXED, __HIP_MEMORY_SCOPE_AGENT); }
__device__ __forceinline__ unsigned xb_add(unsigned* p, unsigned v) { return __hip_atomic_fetch_add(p, v, __ATOMIC_RELAXED, __HIP_MEMORY_SCOPE_AGENT); }
__device__ __forceinline__ unsigned xb_xcc_id() { return (unsigned)__builtin_amdgcn_s_getreg((3 << 11) | 20) & 0xFu; }
#define XB_SPIN(cond, bar) do { unsigned _sp = 0; while (cond) { __builtin_amdgcn_s_sleep(1); \
    if ((++_sp & 255u) == 0u) { if (xb_ld(&(bar)[XB_TMO])) break; if (_sp > XB_SPIN_CAP) { atomicAdd(&(bar)[XB_TMO], 1u); break; } } } } while (0)
struct XcdBarrier { unsigned* bar; unsigned x; volatile LAS unsigned* st; };
__device__ __forceinline__ XcdBarrier xcd_barrier_post(unsigned* bar, volatile LAS unsigned* st) {
    XcdBarrier b; b.bar = bar; b.x = xb_xcc_id(); b.st = st;
    if (threadIdx.x == 0) (void)xb_add(&bar[XB_XCNT(b.x)], 1u);
    return b;
}
__device__ __forceinline__ void xcd_barrier_complete(unsigned* bar, unsigned x, unsigned& nloc, unsigned& nx) {
    const unsigned G = gridDim.x * gridDim.y * gridDim.z;
    unsigned sum, cnt, mine, sp = 0u;
    for (;;) {
        sum = 0u; cnt = 0u; mine = 0u;
#pragma unroll
        for (unsigned j = 0; j < 16; ++j) { const unsigned c = xb_ld(&bar[XB_XCNT(j)]); sum += c; cnt += (c > 0u) ? 1u : 0u; mine = (j == x) ? c : mine; }
        if (sum == G) break;
        __builtin_amdgcn_s_sleep(1);
        if ((++sp & 255u) == 0u) { if (xb_ld(&bar[XB_TMO])) break; if (sp > XB_SPIN_CAP) { atomicAdd(&bar[XB_TMO], 1u); break; } }
    }
    nloc = mine > 0u ? mine : 1u; nx = cnt > 0u ? cnt : 1u;
}
__device__ __forceinline__ void xcd_barrier(const XcdBarrier& b) {
    asm volatile("s_waitcnt vmcnt(0)" ::: "memory");
    __syncthreads();
    if (threadIdx.x == 0) {
        unsigned* bar = b.bar;
        __builtin_amdgcn_s_waitcnt(0);
        unsigned nloc = b.st[0], nx = b.st[1];
        if (nloc == 0u) { xcd_barrier_complete(bar, b.x, nloc, nx); b.st[0] = nloc; b.st[1] = nx; }
        const unsigned old = xb_add(&bar[XB_XSUB(b.x)], 1u);
        const unsigned gen = old / nloc;
        if (old + 1u == (gen + 1u) * nloc) {
            __builtin_amdgcn_fence(__ATOMIC_RELEASE, "agent");
            asm volatile("s_waitcnt vmcnt(0)" ::: "memory");
            const unsigned og = xb_add(&bar[XB_TOP], 1u);
            const unsigned tg = og / nx;
            if (og + 1u == (tg + 1u) * nx) xb_add(&bar[XB_TOPGEN], 1u);
            else XB_SPIN(xb_ld(&bar[XB_TOPGEN]) == tg, bar);
            __builtin_amdgcn_fence(__ATOMIC_ACQUIRE, "agent");
            xb_add(&bar[XB_XGEN(b.x)], 1u);
            asm volatile("s_waitcnt vmcnt(0)" ::: "memory");
        } else {
            XB_SPIN(xb_ld(&bar[XB_XGEN(b.x)]) == gen, bar);
            __builtin_amdgcn_fence(__ATOMIC_ACQUIRE, "agent");
            asm volatile("s_waitcnt vmcnt(0)" ::: "memory");
        }
    }
    __syncthreads();
}

namespace pg8 {
constexpr int BM = 256, BK = 64, HALF = 128, HTB = HALF * BK * 2, STAGE_BYTES = 8 * HTB, NXCD = 8, WGM = 8;
DI int lds_byte(int r, int c) { const int st = (r >> 4) * 2 + (c >> 5), rr = r & 15, cc = c & 31, ob = rr * 64 + cc * 2; return st * 1024 + (ob ^ (((ob >> 9) & 1) << 5)); }
DI void stage_rc(int b, int& R, int& C) { const int st = b / 1024, sb = b % 1024, swz = sb ^ (((sb >> 9) & 1) << 5); R = (st >> 1) * 16 + swz / 64; C = (st & 1) * 32 + (swz % 64) / 2; }
DI int perm32(int rho) { const int n = rho >> 4, i = rho & 15; return 8 * (i >> 2) + 4 * n + (i & 3); }

struct Unit { int pm, pn, e; const char* A; const char* B; };

struct DenseOrder {
    int nM, nN, nwg, G, c; const char* A; const char* Bt; size_t tstepA, tstepB;
    DI void init(const bf16* A_, int lda, const bf16* Bt_, int ldb, int M, int N, int G_, int c_) { nM = M / BM; nN = N / BM; nwg = nM * nN; G = G_; c = c_; A = (const char*)A_; Bt = (const char*)Bt_; tstepA = (size_t)BM * lda * 2; tstepB = (size_t)BM * ldb * 2; }
    DI bool next(int i, Unit& u) const {
        const long L = (long)i * G + c; if (L >= nwg) return false;
        int wgid = (int)L; { const int q = nwg / NXCD, r = nwg % NXCD, xcd = wgid % NXCD, off = wgid / NXCD; wgid = (xcd < r ? xcd * (q + 1) : r * (q + 1) + (xcd - r) * q) + off; }
        const int nig = WGM * nN, gid = wgid / nig, fm = gid * WGM, gsz = (nM - fm) < WGM ? (nM - fm) : WGM;
        u.pm = fm + ((wgid % nig) % gsz); u.pn = (wgid % nig) / gsz; u.e = 0;
        u.A = A + (size_t)u.pm * tstepA; u.B = Bt + (size_t)u.pn * tstepB; return true;
    }
};
struct MoeOrder {
    int nN, nunits, G, c; const char* A; const char* W; size_t estride; const int* tile_e;
    DI void init(const bf16* A_, const bf16* W_, int Nexp, const int* tile_e_, int nmt, int G_, int c_) { nN = Nexp / BM; nunits = nmt * nN; G = G_; c = c_; A = (const char*)A_; W = (const char*)W_; estride = (size_t)Nexp * 1024 * 2; tile_e = tile_e_; }
    DI bool next(int i, Unit& u) const {
        const long L = (long)i * G + c; if (L >= nunits) return false;
        const int l = (int)L; u.pm = l / nN; u.pn = l % nN;
        u.e = (int)__hip_atomic_load((const unsigned*)tile_e + u.pm, __ATOMIC_RELAXED, __HIP_MEMORY_SCOPE_AGENT) & 31;
        u.A = A + (size_t)u.pm * (BM * 1024 * 2); u.B = W + (size_t)u.e * estride + (size_t)u.pn * (BM * 1024 * 2); return true;
    }
};

DI unsigned cvt_pk_bf16(float lo, float hi) { unsigned r; asm volatile("v_cvt_pk_bf16_f32 %0, %1, %2" : "=v"(r) : "v"(lo), "v"(hi)); return r; }

struct EpiF32 {
    static constexpr bool PERM = false;
    float* C; int ldc;
    DI void operator()(const f32x4 (&acc)[2][2][4][2], const Unit& u, int wr, int wc, int fr, int fq) const {
        const int row0 = u.pm * BM + wr * 64 + fr, col0 = u.pn * BM + wc * 32 + 4 * fq;
#pragma unroll
        for (int ai = 0; ai < 2; ++ai)
#pragma unroll
            for (int m = 0; m < 4; ++m) { float* rowp = C + (size_t)(row0 + ai * HALF + m * 16) * ldc + col0;
#pragma unroll
                for (int bj = 0; bj < 2; ++bj)
#pragma unroll
                    for (int n = 0; n < 2; ++n) *(f32x4*)(rowp + bj * HALF + n * 16) = acc[ai][bj][m][n]; }
    }
};
struct EpiBf16 {
    static constexpr bool PERM = true;
    bf16* O; int ldc; const float* bias; int bias_estride;
    DI void operator()(const f32x4 (&acc)[2][2][4][2], const Unit& u, int wr, int wc, int fr, int fq) const {
        const int row0 = u.pm * BM + wr * 64 + fr, col0 = u.pn * BM + wc * 32 + 8 * fq;
        f32x4 bv[2][2];
#pragma unroll
        for (int bj = 0; bj < 2; ++bj)
#pragma unroll
            for (int n = 0; n < 2; ++n) bv[bj][n] = bias ? *(const f32x4*)(bias + (size_t)u.e * bias_estride + col0 + bj * HALF + 4 * n) : (f32x4){0.f, 0.f, 0.f, 0.f};
#pragma unroll
        for (int ai = 0; ai < 2; ++ai)
#pragma unroll
            for (int m = 0; m < 4; ++m) { bf16* rowp = O + (size_t)(row0 + ai * HALF + m * 16) * ldc + col0;
#pragma unroll
                for (int bj = 0; bj < 2; ++bj) { const f32x4 v0 = acc[ai][bj][m][0] + bv[bj][0], v1 = acc[ai][bj][m][1] + bv[bj][1];
                    u32x4 w; w.x = cvt_pk_bf16(v0[0], v0[1]); w.y = cvt_pk_bf16(v0[2], v0[3]); w.z = cvt_pk_bf16(v1[0], v1[1]); w.w = cvt_pk_bf16(v1[2], v1[3]);
                    *(u32x4*)(rowp + bj * HALF) = w; } }
    }
};
struct EpiSwiglu {
    static constexpr bool PERM = true;
    bf16* O; const float* bias;
    DI void operator()(const f32x4 (&acc)[2][2][4][2], const Unit& u, int wr, int wc, int fr, int fq) const {
        const int row0 = u.pm * BM + wr * 64 + fr, cw = u.pn * HALF + wc * 32 + 8 * fq;
        const float* bb = bias + (size_t)u.e * 2048 + cw;
        f32x4 bg[2], bu[2];
#pragma unroll
        for (int n = 0; n < 2; ++n) { bg[n] = *(const f32x4*)(bb + 4 * n); bu[n] = *(const f32x4*)(bb + 1024 + 4 * n); }
#pragma unroll
        for (int ai = 0; ai < 2; ++ai)
#pragma unroll
            for (int m = 0; m < 4; ++m) {
                float r[8];
#pragma unroll
                for (int n = 0; n < 2; ++n)
#pragma unroll
                    for (int j = 0; j < 4; ++j) {
                        const float g = fminf(acc[ai][0][m][n][j] + bg[n][j], 7.0f);
                        const float up = fminf(fmaxf(acc[ai][1][m][n][j] + bu[n][j], -7.0f), 7.0f);
                        r[n * 4 + j] = (up + 1.0f) * (g / (1.0f + __expf(-1.702f * g)));
                    }
                u32x4 w; w.x = cvt_pk_bf16(r[0], r[1]); w.y = cvt_pk_bf16(r[2], r[3]); w.z = cvt_pk_bf16(r[4], r[5]); w.w = cvt_pk_bf16(r[6], r[7]);
                *(u32x4*)(O + (size_t)(row0 + ai * HALF + m * 16) * 1024 + cw) = w;
            }
    }
};

template <class Epi, class Sched>
DI void gemm_phase(LAS unsigned char* lds, const int lda, const int ldb, const int K, const Sched& S, const Epi& E) {
    const int tid = threadIdx.x, wid = __builtin_amdgcn_readfirstlane(tid >> 6), lane = tid & 63, wr = wid >> 2, wc = wid & 3, fr = lane & 15, fq = lane >> 4;
    const int nt = K / BK;
    unsigned voffA[2], voffB[2];
#pragma unroll
    for (int i = 0; i < 2; ++i) { int R, C; stage_rc(tid * 16 + i * 8192, R, C); const int Rb = Epi::PERM ? ((R & ~31) + perm32(R & 31)) : R;
        voffA[i] = (unsigned)(R * lda + C) * 2u; voffB[i] = (unsigned)(Rb * ldb + C) * 2u; }
    const size_t kstep = (size_t)(BK * 2);
    const size_t hstepA = (size_t)HALF * lda * 2, hstepB = (size_t)HALF * ldb * 2;
    const unsigned ldsw = (unsigned)wid * 1024u;
    const int aoff = lds_byte(wr * 64 + fr, fq * 8), boff = lds_byte(wc * 32 + fr, fq * 8);
#define PG8_SA(b, h) (((b) * 2 + (h)) * HTB)
#define PG8_SB(b, h) ((4 + (b) * 2 + (h)) * HTB)
#define PG8_STAGE(bufoff, gbase, voff) do { _Pragma("unroll") for (int _i = 0; _i < 2; ++_i) \
        __builtin_amdgcn_global_load_lds((const unsigned*)((const char*)(gbase) + (voff)[_i]), (LAS unsigned*)(lds + (bufoff) + ldsw + _i * 8192), 16, 0, 0); } while (0)
#define PG8_LDA(dst, b, h) do { _Pragma("unroll") for (int m = 0; m < 4; ++m) _Pragma("unroll") for (int k = 0; k < 2; ++k) dst[m][k] = *(const LAS bf16x8*)(lds + PG8_SA(b, h) + aoff + m * 2048 + k * 1024); } while (0)
#define PG8_LDB(dst, b, h) do { _Pragma("unroll") for (int n = 0; n < 2; ++n) _Pragma("unroll") for (int k = 0; k < 2; ++k) dst[n][k] = *(const LAS bf16x8*)(lds + PG8_SB(b, h) + boff + n * 2048 + k * 1024); } while (0)
#define PG8_MMA(ai, bj, At, Bt) do { __builtin_amdgcn_s_setprio(1); _Pragma("unroll") for (int m = 0; m < 4; ++m) _Pragma("unroll") for (int n = 0; n < 2; ++n) _Pragma("unroll") for (int k = 0; k < 2; ++k) \
        acc[ai][bj][m][n] = __builtin_amdgcn_mfma_f32_16x16x32_bf16(Bt[n][k], At[m][k], acc[ai][bj][m][n], 0, 0, 0); __builtin_amdgcn_s_setprio(0); } while (0)
#define PG8_WAIT_V(n) asm volatile("s_waitcnt vmcnt(" #n ")" ::: "memory")
#define PG8_WAIT_L(n) asm volatile("s_waitcnt lgkmcnt(" #n ")" ::: "memory")
#define PG8_BAR __builtin_amdgcn_s_barrier()
#define PG8_SCHED __builtin_amdgcn_sched_barrier(0)
    Unit cur, nxt; int ui = 0;
    if (!S.next(0, cur)) return;
    f32x4 acc[2][2][4][2];
#pragma unroll
    for (int a = 0; a < 2; ++a)
#pragma unroll
        for (int b = 0; b < 2; ++b)
#pragma unroll
            for (int m = 0; m < 4; ++m)
#pragma unroll
                for (int n = 0; n < 2; ++n) acc[a][b][m][n] = (f32x4){0.f, 0.f, 0.f, 0.f};
    bf16x8 At[4][2], B0[2][2], B1[2][2];
    const char* cA = cur.A; const char* cB = cur.B;
    PG8_STAGE(PG8_SB(0, 0), cB, voffB); PG8_STAGE(PG8_SA(0, 0), cA, voffA); PG8_STAGE(PG8_SB(0, 1), cB + hstepB, voffB); PG8_STAGE(PG8_SA(0, 1), cA + hstepA, voffA);
    if (wr == 1) PG8_BAR;
    PG8_WAIT_V(4); PG8_BAR;
    PG8_STAGE(PG8_SB(1, 0), cB + kstep, voffB); PG8_STAGE(PG8_SA(1, 0), cA + kstep, voffA); PG8_STAGE(PG8_SB(1, 1), cB + hstepB + kstep, voffB);
    PG8_WAIT_V(6); PG8_BAR;
    for (;;) {
        const bool has_next = S.next(ui + 1, nxt);
        const char* nA = has_next ? nxt.A : cA; const char* nB = has_next ? nxt.B : cB;
        for (int t = 0; t < nt; t += 2) {
            const bool last = (t == nt - 2);
            const char* a1 = cA + (size_t)(t + 1) * kstep;
            const char* a2 = last ? nA : cA + (size_t)(t + 2) * kstep; const char* b2 = last ? nB : cB + (size_t)(t + 2) * kstep;
            const char* a3 = a2 + kstep; const char* b3 = b2 + kstep;
            PG8_LDB(B0, 0, 0); PG8_SCHED; PG8_LDA(At, 0, 0); PG8_STAGE(PG8_SA(1, 1), a1 + hstepA, voffA);
            PG8_WAIT_L(8); PG8_BAR; PG8_WAIT_L(0); PG8_MMA(0, 0, At, B0); PG8_BAR; PG8_SCHED;
            PG8_LDB(B1, 0, 1); PG8_STAGE(PG8_SB(0, 0), b2, voffB);
            PG8_BAR; PG8_WAIT_L(0); PG8_MMA(0, 1, At, B1); PG8_BAR;
            PG8_LDA(At, 0, 1); PG8_STAGE(PG8_SA(0, 0), a2, voffA);
            PG8_BAR; PG8_WAIT_L(0); PG8_MMA(1, 0, At, B0); PG8_BAR; PG8_SCHED;
            PG8_STAGE(PG8_SB(0, 1), b2 + hstepB, voffB);
            PG8_WAIT_V(6); PG8_BAR; PG8_MMA(1, 1, At, B1); PG8_BAR;
            PG8_LDB(B0, 1, 0); PG8_SCHED; PG8_LDA(At, 1, 0); PG8_STAGE(PG8_SA(0, 1), a2 + hstepA, voffA);
            PG8_WAIT_L(8); PG8_BAR; PG8_WAIT_L(0); PG8_MMA(0, 0, At, B0); PG8_BAR; PG8_SCHED;
            PG8_LDB(B1, 1, 1); PG8_STAGE(PG8_SB(1, 0), b3, voffB);
            PG8_BAR; PG8_WAIT_L(0); PG8_MMA(0, 1, At, B1); PG8_BAR;
            PG8_LDA(At, 1, 1); PG8_STAGE(PG8_SA(1, 0), a3, voffA);
            PG8_BAR; PG8_WAIT_L(0); PG8_MMA(1, 0, At, B0); PG8_BAR; PG8_SCHED;
            PG8_STAGE(PG8_SB(1, 1), b3 + hstepB, voffB);
            PG8_WAIT_V(6); PG8_BAR; PG8_MMA(1, 1, At, B1); PG8_BAR;
        }
        E(acc, cur, wr, wc, fr, fq);
        if (!has_next) break;
#pragma unroll
        for (int a = 0; a < 2; ++a)
#pragma unroll
            for (int b = 0; b < 2; ++b)
#pragma unroll
                for (int m = 0; m < 4; ++m)
#pragma unroll
                    for (int n = 0; n < 2; ++n) acc[a][b][m][n] = (f32x4){0.f, 0.f, 0.f, 0.f};
        cur = nxt; cA = nA; cB = nB; ++ui;
    }
    PG8_WAIT_V(0);
    if (wr == 0) PG8_BAR;
    PG8_BAR;
#undef PG8_SA
#undef PG8_SB
#undef PG8_STAGE
#undef PG8_LDA
#undef PG8_LDB
#undef PG8_MMA
#undef PG8_WAIT_V
#undef PG8_WAIT_L
#undef PG8_BAR
#undef PG8_SCHED
}
}

struct Args { const void* in[29]; float* out; unsigned char* ws; int ph_lo, ph_hi; };

struct Ctx {
    LAS unsigned char* lds; unsigned char* ws; const Args* a;
    int tid, lane, wave, bid, G, gw, NGW;
};
#define WSP(type, off) ((type*)(C.ws + (off)))
#define INP(type, i) ((const type*)(C.a->in[i]))

DI void transpose_item(const float* W, int K, int N, int nblk, bf16* WT, int mode, LAS float* scr, int item, int lane) {
    const int kb = item / nblk, nb = item % nblk, k0 = 64 * kb, n0 = 32 * nb;
    const int n = n0 + (lane & 31); const bool ok = n < N;
#pragma unroll 8
    for (int i = 0; i < 32; ++i) { const int kk = 2 * i + (lane >> 5); scr[kk * 33 + (lane & 31)] = ok ? W[(size_t)(k0 + kk) * N + n] : 0.f; }
    LDS_WAIT();
    const int c = lane & 7;
    int orow0 = n0;
    if (mode == 1) orow0 = (n0 < 1024) ? ((n0 >> 7) * 256 + (n0 & 127)) : ((((n0 - 1024) >> 7) * 256) + 128 + ((n0 - 1024) & 127));
#pragma unroll
    for (int j = 0; j < 4; ++j) { const int nn = (lane >> 3) + 8 * j; const LAS float* s = scr + (8 * c) * 33 + nn;
        u32x4 o; o.x = pk2(s[0 * 33], s[1 * 33]); o.y = pk2(s[2 * 33], s[3 * 33]); o.z = pk2(s[4 * 33], s[5 * 33]); o.w = pk2(s[6 * 33], s[7 * 33]);
        *(u32x4*)(WT + (size_t)(orow0 + nn) * K + k0 + 8 * c) = o; }
    LDS_WAIT();
}

DI void phase_convert(const Ctx& C) {
    LAS float* scr = (LAS float*)(C.lds + C.wave * 16384);
    constexpr int I_EVEN = 16 * (EVEN_PAD / 32), I_ODD = 16 * (ODD_IN / 32), I_SQ = 16 * 32, I_KV = 16 * 64, I_GU = 16 * 64, I_DN = 16 * 32;
    constexpr int NITEMS = I_EVEN + I_ODD + 2 * I_SQ + 2 * I_SQ + 2 * I_KV + 2 * I_SQ + 64 * I_GU + 64 * I_DN;
    for (int it = C.gw; it < NITEMS; it += C.NGW) {
        int r = it;
        if (r < I_EVEN) { transpose_item(INP(float, 3), 1024, EVEN_IN, EVEN_PAD / 32, WSP(bf16, WS_WEVEN), 0, scr, r, C.lane); continue; } r -= I_EVEN;
        if (r < I_ODD) { transpose_item(INP(float, 12), 1024, ODD_IN, ODD_IN / 32, WSP(bf16, WS_WODD), 0, scr, r, C.lane); continue; } r -= I_ODD;
        if (r < I_SQ) { transpose_item(INP(float, 11), 1024, 1024, 32, WSP(bf16, WS_WOUTE), 0, scr, r, C.lane); continue; } r -= I_SQ;
        if (r < I_SQ) { transpose_item(INP(float, 17), 1024, 1024, 32, WSP(bf16, WS_WOUTO), 0, scr, r, C.lane); continue; } r -= I_SQ;
        if (r < 2 * I_SQ) { const int l = r / I_SQ; transpose_item(INP(float, 18) + (size_t)l * 1024 * 1024, 1024, 1024, 32, WSP(bf16, WS_WXQ) + (size_t)l * 1024 * 1024, 0, scr, r % I_SQ, C.lane); continue; } r -= 2 * I_SQ;
        if (r < 2 * I_KV) { const int l = r / I_KV; transpose_item(INP(float, 19) + (size_t)l * 1024 * 2048, 1024, 2048, 64, WSP(bf16, WS_WXKV) + (size_t)l * 2048 * 1024, 0, scr, r % I_KV, C.lane); continue; } r -= 2 * I_KV;
        if (r < 2 * I_SQ) { const int l = r / I_SQ; transpose_item(INP(float, 20) + (size_t)l * 1024 * 1024, 1024, 1024, 32, WSP(bf16, WS_WXO) + (size_t)l * 1024 * 1024, 0, scr, r % I_SQ, C.lane); continue; } r -= 2 * I_SQ;
        if (r < 64 * I_GU) { const int le = r / I_GU; transpose_item(INP(float, 25) + (size_t)le * 1024 * 2048, 1024, 2048, 64, WSP(bf16, WS_WGU) + (size_t)le * 2048 * 1024, 1, scr, r % I_GU, C.lane); continue; } r -= 64 * I_GU;
        { const int le = r / I_DN; transpose_item(INP(float, 27) + (size_t)le * 1024 * 1024, 1024, 1024, 32, WSP(bf16, WS_WDN) + (size_t)le * 1024 * 1024, 0, scr, r % I_DN, C.lane); }
    }
    const size_t gt = (size_t)C.bid * NTHREADS + C.tid, ngt = (size_t)C.G * NTHREADS;
    { const f32x4* x4 = INP(f32x4, 0); u32x2* o = WSP(u32x2, WS_XB);
      for (size_t i = gt; i < (size_t)T * DM / 4; i += ngt) { const f32x4 v = x4[i]; u32x2 w; w.x = pk2(v[0], v[1]); w.y = pk2(v[2], v[3]); o[i] = w; } }
    { const f32x4* x4 = INP(f32x4, 1); u32x2* o = WSP(u32x2, WS_MEMB);
      for (size_t i = gt; i < (size_t)NB * 256 * DM / 4; i += ngt) { const f32x4 v = x4[i]; u32x2 w; w.x = pk2(v[0], v[1]); w.y = pk2(v[2], v[3]); o[i] = w; } }
    { const int* pos = INP(int, 2); float* rc = WSP(float, WS_ROPEC); float* rs = WSP(float, WS_ROPES);
      for (size_t i = gt; i < (size_t)T * 32; i += ngt) { const int t = (int)(i >> 5), d = (int)(i & 31);
          const double inv = exp2(-(double)d * (13.287712379549449 / 32.0));
          const double ang = (double)pos[t] * inv;
          rc[i] = (float)cos(ang); rs[i] = (float)sin(ang); } }
}

DI void phase_nsa_prep(const Ctx& C) {
    const bf16* PROJ = WSP(bf16, R_PROJ); const float* RC = WSP(float, WS_ROPEC); const float* RS = WSP(float, WS_ROPES);
    bf16* QN = WSP(bf16, R_QN); bf16* QR = WSP(bf16, R_QR);
    bf16* KV6[6] = {WSP(bf16, R_KCMP), WSP(bf16, R_VCMP), WSP(bf16, R_KSLC), WSP(bf16, R_VSLC), WSP(bf16, R_KWIN), WSP(bf16, R_VWIN)};
    float* GATES = WSP(float, R_GATES); bf16* UG = WSP(bf16, R_UG); bf16* VN = WSP(bf16, R_VN);
    const float* lng = INP(float, 7); const float* lnb = INP(float, 8);
    const int lane = C.lane;
    for (int t = C.gw; t < T; t += C.NGW) {
        const bf16* pr = PROJ + (size_t)t * EVEN_PAD;
        const int b = t / SEQ, s = t % SEQ;
        const float cs = RC[(size_t)t * 32 + (lane & 31)], sn = RS[(size_t)t * 32 + (lane & 31)];
#pragma unroll
        for (int h = 0; h < 8; ++h) {
            const bf16 raw = pr[h * 64 + lane]; const float v = bf2f(raw); const float pv = __shfl_xor(v, 32);
            const float r = (lane < 32) ? (v * cs - pv * sn) : (v * cs + pv * sn);
            QN[(size_t)t * 512 + h * 64 + lane] = raw; QR[(size_t)t * 512 + h * 64 + lane] = (bf16)f2bf(r);
        }
#pragma unroll
        for (int i = 0; i < 6; ++i)
#pragma unroll
            for (int g = 0; g < 2; ++g) {
                const bf16 raw = pr[512 + i * 128 + g * 64 + lane]; bf16 o = raw;
                if (i == 2 || i == 4) { const float v = bf2f(raw); const float pv = __shfl_xor(v, 32); const float r = (lane < 32) ? (v * cs - pv * sn) : (v * cs + pv * sn); o = (bf16)f2bf(r); }
                KV6[i][((size_t)(b * 2 + g) * SEQ + s) * 64 + lane] = o;
            }
        if (lane < 24) GATES[(size_t)t * 24 + lane] = sigmoidf(bf2f(pr[1280 + lane]));
#pragma unroll
        for (int j = 0; j < 8; ++j) { const int c = lane + 64 * j; UG[(size_t)t * 512 + c] = (bf16)f2bf(gelu_tanh(bf2f(pr[1304 + c]))); }
#pragma unroll
        for (int g = 0; g < 4; ++g) {
            const float a0 = gelu_tanh(bf2f(pr[1816 + g * 128 + lane])), a1 = gelu_tanh(bf2f(pr[1816 + g * 128 + 64 + lane]));
            const float mean = wave_sum(a0 + a1) * (1.0f / 128.0f); const float d0 = a0 - mean, d1 = a1 - mean;
            const float var = wave_sum(d0 * d0 + d1 * d1) * (1.0f / 128.0f); const float rstd = 1.0f / sqrtf(var + 1e-5f);
            VN[(size_t)t * 512 + g * 128 + lane] = (bf16)f2bf(d0 * rstd * lng[g * 128 + lane] + lnb[g * 128 + lane]);
            VN[(size_t)t * 512 + g * 128 + 64 + lane] = (bf16)f2bf(d1 * rstd * lng[g * 128 + 64 + lane] + lnb[g * 128 + 64 + lane]);
        }
    }
}

DI void phase_cmp_hidden(const Ctx& C) {
    const int lane = C.lane; float* H1 = WSP(float, R_H1);
    constexpr int NIT = 2 * 8 * 2 * 255 * 4;
    for (int it0 = C.gw; it0 < NIT; it0 += C.NGW) {
        const int it = __builtin_amdgcn_readfirstlane(it0);
        const int jq = it & 3; int r = it >> 2; const int c = r % 255; r /= 255; const int g = r & 1; r >>= 1; const int b = r & 7; const int kv = r >> 3;
        const bf16* src = (kv ? WSP(bf16, R_VCMP) : WSP(bf16, R_KCMP)) + ((size_t)(b * 2 + g) * SEQ + 16 * c) * 64;
        const float* pos = INP(float, 4) + kv * 2048; const float* w = INP(float, 5) + (size_t)kv * 2048 * 256 + jq * 64 + lane;
        float acc = 0.f;
        for (int k = 0; k < 2048; k += 8) {
            const bf16x8 a8 = *(const bf16x8*)(src + k); const f32x4 p0 = *(const f32x4*)(pos + k), p1 = *(const f32x4*)(pos + k + 4);
#pragma unroll
            for (int e = 0; e < 8; ++e) { const float a = bf2f((bf16)a8[e]) + (e < 4 ? p0[e] : p1[e - 4]); acc += a * w[(size_t)(k + e) * 256]; }
        }
        H1[((size_t)kv * 4096 + (b * 2 + g) * 256 + c) * 256 + jq * 64 + lane] = gelu_tanh(acc);
    }
}
DI void phase_cmp_out(const Ctx& C) {
    const int lane = C.lane; const float* H1 = WSP(float, R_H1);
    for (int it0 = C.gw; it0 < 2 * 4096; it0 += C.NGW) {
        const int it = __builtin_amdgcn_readfirstlane(it0);
        const int kv = it >> 12, row = it & 4095, c = row & 255;
        bf16* dst = (kv ? WSP(bf16, R_VC) : WSP(bf16, R_KC)) + (size_t)row * 64 + lane;
        if (c == 255) { *dst = 0; continue; }
        const float* h = H1 + ((size_t)kv * 4096 + row) * 256; const float* w2 = INP(float, 6) + (size_t)kv * 256 * 64 + lane;
        float acc = 0.f;
        for (int j = 0; j < 256; ++j) acc += h[j] * w2[j * 64];
        *dst = (bf16)f2bf(acc);
    }
}

template <int D, int NH>
DI void wave_attn_blocks(const LAS float* qs, const bf16* Kb, size_t kstride, const bf16* Vb, size_t vstride, u64 blkmask, int spos, int window,
                         float (&o)[NH][D / 64], float (&m)[NH], float (&l)[NH], int lane) {
    while (blkmask) {
        const int j = __builtin_ctzll(blkmask); blkmask &= blkmask - 1;
        const int key = 64 * j + lane; const bool valid = (key <= spos) && (spos - key < window);
        const bf16* kr = Kb + (size_t)key * kstride;
        float sc[NH];
#pragma unroll
        for (int h = 0; h < NH; ++h) sc[h] = 0.f;
#pragma unroll 2
        for (int d0 = 0; d0 < D; d0 += 8) {
            const bf16x8 kk = *(const bf16x8*)(kr + d0);
#pragma unroll
            for (int h = 0; h < NH; ++h) { const f32x4 q0 = *(const LAS f32x4*)(qs + h * D + d0), q1 = *(const LAS f32x4*)(qs + h * D + d0 + 4);
#pragma unroll
                for (int e = 0; e < 8; ++e) sc[h] += (e < 4 ? q0[e] : q1[e - 4]) * bf2f((bf16)kk[e]); }
        }
        float p[NH];
#pragma unroll
        for (int h = 0; h < NH; ++h) {
            const float sv = valid ? sc[h] : -1e30f; const float bm = wave_max(sv); const float mn = fmaxf(m[h], bm);
            const float corr = __expf(m[h] - mn); p[h] = valid ? __expf(sc[h] - mn) : 0.f;
            l[h] = l[h] * corr + wave_sum(p[h]); m[h] = mn;
#pragma unroll
            for (int r = 0; r < D / 64; ++r) o[h][r] *= corr;
        }
#pragma unroll 4
        for (int i = 0; i < 64; ++i) {
            const bf16* vr = Vb + (size_t)(64 * j + i) * vstride + lane;
            float vv[D / 64];
#pragma unroll
            for (int r = 0; r < D / 64; ++r) vv[r] = bf2f(vr[64 * r]);
#pragma unroll
            for (int h = 0; h < NH; ++h) { const float pi = rdlane(p[h], i);
#pragma unroll
                for (int r = 0; r < D / 64; ++r) o[h][r] += pi * vv[r]; }
        }
    }
}

DI void phase_cmp_attn(const Ctx& C) {
    const int lane = C.lane;
    LAS float* qs = (LAS float*)(C.lds + C.wave * 16384); LAS float* Pl = qs + 256;
    const bf16* QN = WSP(bf16, R_QN); const float* GATES = WSP(float, R_GATES); float* OCMP = WSP(float, R_OCMP); u64* SELM = WSP(u64, R_SELM);
    for (int it0 = C.gw; it0 < T * 2; it0 += C.NGW) {
        const int it = __builtin_amdgcn_readfirstlane(it0);
        const int g = it & 1, t = it >> 1, b = t / SEQ, s = t % SEQ;
#pragma unroll
        for (int hh = 0; hh < 4; ++hh) qs[hh * 64 + lane] = bf2f(QN[(size_t)t * 512 + (g * 4 + hh) * 64 + lane]) * 0.125f;
        LDS_WAIT();
        const int nvalid = s >= 31 ? (s - 31) / 16 + 1 : 0;
        const bf16* KCb = WSP(bf16, R_KC) + (size_t)(b * 2 + g) * 256 * 64; const bf16* VCb = WSP(bf16, R_VC) + (size_t)(b * 2 + g) * 256 * 64;
        float p[4][4];
#pragma unroll
        for (int k = 0; k < 4; ++k) {
            const int c = lane + 64 * k; const bf16* kr = KCb + (size_t)c * 64;
            float sc[4] = {0.f, 0.f, 0.f, 0.f};
#pragma unroll 2
            for (int d0 = 0; d0 < 64; d0 += 8) { const bf16x8 kk = *(const bf16x8*)(kr + d0);
#pragma unroll
                for (int hh = 0; hh < 4; ++hh) { const f32x4 q0 = *(const LAS f32x4*)(qs + hh * 64 + d0), q1 = *(const LAS f32x4*)(qs + hh * 64 + d0 + 4);
#pragma unroll
                    for (int e = 0; e < 8; ++e) sc[hh] += (e < 4 ? q0[e] : q1[e - 4]) * bf2f((bf16)kk[e]); } }
#pragma unroll
            for (int hh = 0; hh < 4; ++hh) p[hh][k] = (c < nvalid) ? sc[hh] : -1e30f;
        }
        float psum[4] = {0.f, 0.f, 0.f, 0.f};
#pragma unroll
        for (int hh = 0; hh < 4; ++hh) {
            const float mx = wave_max(fmaxf(fmaxf(p[hh][0], p[hh][1]), fmaxf(p[hh][2], p[hh][3])));
            float ls = 0.f;
#pragma unroll
            for (int k = 0; k < 4; ++k) { const int c = lane + 64 * k; p[hh][k] = (c < nvalid) ? __expf(p[hh][k] - mx) : 0.f; ls += p[hh][k]; }
            ls = wave_sum(ls); const float inv = ls > 0.f ? 1.0f / ls : 0.f;
#pragma unroll
            for (int k = 0; k < 4; ++k) { p[hh][k] *= inv; psum[k] += p[hh][k]; }
        }
#pragma unroll
        for (int k = 0; k < 4; ++k) Pl[lane + 64 * k] = psum[k];
        LDS_WAIT();
        float imp = Pl[4 * lane] + Pl[4 * lane + 1] + Pl[4 * lane + 2] + 0.5f * Pl[4 * lane + 3];
        if (lane > 0) imp += 0.5f * Pl[4 * lane - 1];
        const int cur = s >> 6;
        const bool forced = (lane == 0) || (lane == cur) || (lane == cur - 1);
        const float score = forced ? 1e4f : (lane <= cur ? imp : -1.0f);
        int rank = 0;
#pragma unroll 8
        for (int i = 0; i < 64; ++i) { const float si = rdlane(score, i); rank += (si > score || (si == score && i < lane)) ? 1 : 0; }
        const u64 mask = __ballot(rank < 16);
        if (lane == 0) SELM[(size_t)(b * 2 + g) * SEQ + s] = mask;
        float o[4] = {0.f, 0.f, 0.f, 0.f};
#pragma unroll
        for (int k = 0; k < 4; ++k) {
            const int lim = nvalid - 64 * k < 64 ? nvalid - 64 * k : 64;
#pragma unroll 4
            for (int i = 0; i < lim; ++i) { const float vv = bf2f(VCb[(size_t)(64 * k + i) * 64 + lane]);
#pragma unroll
                for (int hh = 0; hh < 4; ++hh) o[hh] += rdlane(p[hh][k], i) * vv; }
        }
#pragma unroll
        for (int hh = 0; hh < 4; ++hh) OCMP[(size_t)t * 512 + (g * 4 + hh) * 64 + lane] = GATES[(size_t)t * 24 + g * 12 + hh * 3 + 0] * o[hh];
    }
}

DI void phase_slc_win_sgu(const Ctx& C) {
    const int lane = C.lane;
    LAS float* qs = (LAS float*)(C.lds + C.wave * 16384);
    const bf16* QR = WSP(bf16, R_QR); const float* GATES = WSP(float, R_GATES); const float* OCMP = WSP(float, R_OCMP); const u64* SELM = WSP(u64, R_SELM);
    bf16* MIXIN = WSP(bf16, WS_MIXIN);
    for (int it0 = C.gw; it0 < T * 2; it0 += C.NGW) {
        const int it = __builtin_amdgcn_readfirstlane(it0);
        const int g = it & 1, t = it >> 1, b = t / SEQ, s = t % SEQ, cur = s >> 6;
#pragma unroll
        for (int hh = 0; hh < 4; ++hh) qs[hh * 64 + lane] = bf2f(QR[(size_t)t * 512 + (g * 4 + hh) * 64 + lane]) * 0.125f;
        LDS_WAIT();
        const size_t kvo = (size_t)(b * 2 + g) * SEQ * 64;
        const u64 upto = (cur == 63) ? ~0ull : ((2ull << cur) - 1ull);
        float res[4];
        {   float o[4][1] = {{0.f}, {0.f}, {0.f}, {0.f}}, m[4] = {-1e30f, -1e30f, -1e30f, -1e30f}, l[4] = {0.f, 0.f, 0.f, 0.f};
            const u64 msk = SELM[(size_t)(b * 2 + g) * SEQ + s] & upto;
            wave_attn_blocks<64, 4>(qs, WSP(bf16, R_KSLC) + kvo, 64, WSP(bf16, R_VSLC) + kvo, 64, msk, s, 1 << 30, o, m, l, lane);
#pragma unroll
            for (int hh = 0; hh < 4; ++hh) res[hh] = GATES[(size_t)t * 24 + g * 12 + hh * 3 + 1] * (l[hh] > 0.f ? o[hh][0] / l[hh] : 0.f);
        }
        {   float o[4][1] = {{0.f}, {0.f}, {0.f}, {0.f}}, m[4] = {-1e30f, -1e30f, -1e30f, -1e30f}, l[4] = {0.f, 0.f, 0.f, 0.f};
            const int lo = cur - 8 > 0 ? cur - 8 : 0; const u64 msk = upto & ~((1ull << lo) - 1ull);
            wave_attn_blocks<64, 4>(qs, WSP(bf16, R_KWIN) + kvo, 64, WSP(bf16, R_VWIN) + kvo, 64, msk, s, 512, o, m, l, lane);
#pragma unroll
            for (int hh = 0; hh < 4; ++hh) res[hh] += GATES[(size_t)t * 24 + g * 12 + hh * 3 + 2] * (l[hh] > 0.f ? o[hh][0] / l[hh] : 0.f);
        }
#pragma unroll
        for (int hh = 0; hh < 4; ++hh) { const size_t idx = (size_t)t * 512 + (g * 4 + hh) * 64 + lane; MIXIN[(size_t)t * 1024 + (g * 4 + hh) * 64 + lane] = (bf16)f2bf(OCMP[idx] + res[hh]); }
    }
    const bf16* VN = WSP(bf16, R_VN); const bf16* UG = WSP(bf16, R_UG); const float* sw = INP(float, 9); const float* sb = INP(float, 10);
    for (int it0 = C.gw; it0 < NB * 32 * 4 * 128; it0 += C.NGW) {
        const int it = __builtin_amdgcn_readfirstlane(it0);
        const int tt = it & 127, g = (it >> 7) & 3, n = (it >> 9) & 31, b = it >> 14;
        const size_t tok0 = (size_t)b * SEQ + n * 128;
        const float* wrow = sw + (size_t)(g * 128 + tt) * 128;
        float a0 = 0.f, a1 = 0.f;
        for (int s2 = 0; s2 <= tt; ++s2) { const float w = wrow[s2]; const bf16* vr = VN + (tok0 + s2) * 512 + g * 128 + lane; a0 += w * bf2f(vr[0]); a1 += w * bf2f(vr[64]); }
        const float bias = sb[g * 128 + tt]; const size_t tok = tok0 + tt;
        MIXIN[tok * 1024 + 512 + g * 128 + lane] = (bf16)f2bf(bf2f(UG[tok * 512 + g * 128 + lane]) * (a0 + bias));
        MIXIN[tok * 1024 + 512 + g * 128 + 64 + lane] = (bf16)f2bf(bf2f(UG[tok * 512 + g * 128 + 64 + lane]) * (a1 + bias));
    }
}

DI void ln_row_finish(f32x4 (&v)[4], const float* gam, const float* bet, float* xo, bf16* xb, int lane) {
    float s = 0.f;
#pragma unroll
    for (int j = 0; j < 4; ++j) s += (v[j][0] + v[j][1]) + (v[j][2] + v[j][3]);
    const float mean = wave_sum(s) * (1.0f / DM); float s2 = 0.f;
#pragma unroll
    for (int j = 0; j < 4; ++j) { v[j] = v[j] - mean; s2 += (v[j][0] * v[j][0] + v[j][1] * v[j][1]) + (v[j][2] * v[j][2] + v[j][3] * v[j][3]); }
    const float rstd = 1.0f / sqrtf(wave_sum(s2) * (1.0f / DM) + 1e-5f);
#pragma unroll
    for (int j = 0; j < 4; ++j) { const f32x4 gg = ((const f32x4*)gam)[lane + 64 * j], bb = ((const f32x4*)bet)[lane + 64 * j];
        const f32x4 r = v[j] * rstd * gg + bb; ((f32x4*)xo)[lane + 64 * j] = r;
        u32x2 w; w.x = pk2(r[0], r[1]); w.y = pk2(r[2], r[3]); ((u32x2*)xb)[lane + 64 * j] = w; }
}
DI void phase_ln(const Ctx& C, const float* xprev, const float* y, const float* gam, const float* bet, float* xnext, bf16* xb) {
    for (int t = C.gw; t < T; t += C.NGW) {
        f32x4 v[4];
#pragma unroll
        for (int j = 0; j < 4; ++j) v[j] = ((const f32x4*)(xprev + (size_t)t * DM))[C.lane + 64 * j] * ALPHA + ((const f32x4*)(y + (size_t)t * DM))[C.lane + 64 * j];
        ln_row_finish(v, gam, bet, xnext + (size_t)t * DM, xb + (size_t)t * DM, C.lane);
    }
}

DI void phase_xattn(const Ctx& C, int layer) {
    const int lane = C.lane;
    LAS float* qs = (LAS float*)(C.lds + C.wave * 16384);
    const bf16* XQ = WSP(bf16, WS_XQ); const bf16* XKV = WSP(bf16, WS_XKV) + (size_t)layer * 2048 * 2048; bf16* XO = WSP(bf16, WS_XO);
    for (int it0 = C.gw; it0 < T * 4; it0 += C.NGW) {
        const int it = __builtin_amdgcn_readfirstlane(it0);
        const int h = it & 3, t = it >> 2, b = t / SEQ;
#pragma unroll
        for (int r = 0; r < 4; ++r) qs[lane + 64 * r] = bf2f(XQ[(size_t)t * 1024 + h * 256 + lane + 64 * r]) * 0.0625f;
        LDS_WAIT();
        float o[1][4] = {{0.f, 0.f, 0.f, 0.f}}, m[1] = {-1e30f}, l[1] = {0.f};
        const bf16* Kb = XKV + (size_t)b * 256 * 2048 + h * 256;
        wave_attn_blocks<256, 1>(qs, Kb, 2048, Kb + 1024, 2048, 0xFull, 1 << 29, 1 << 30, o, m, l, lane);
        const float inv = 1.0f / l[0];
#pragma unroll
        for (int r = 0; r < 4; ++r) XO[(size_t)t * 1024 + h * 256 + lane + 64 * r] = (bf16)f2bf(o[0][r] * inv);
    }
}

DI void phase_router(const Ctx& C, int layer, const float* x) {
    const int lane = C.lane, e = lane & 31, half = lane >> 5;
    unsigned char* tab = C.ws + WS_MOETAB + (size_t)layer * 2 * MiB;
    int* TOKE = (int*)(tab + MT_TOKE); float* TOKG = (float*)(tab + MT_TOKG); int* HIST = (int*)(tab + MT_HIST);
    const float* rw = INP(float, 23) + (size_t)layer * 1024 * 32; const float* rb = INP(float, 24) + layer * 32;
    LAS int* hist = (LAS int*)(C.lds + 8 * 16384);
    for (int chunk = C.bid; chunk < 256; chunk += C.G) {
        if (C.tid < 32) hist[C.tid] = 0;
        __syncthreads();
        for (int i = 0; i < 16; ++i) {
            const int t = chunk * 128 + C.wave * 16 + i;
            const float* xr = x + (size_t)t * DM + half * 512;
            float acc = 0.f;
            for (int k = 0; k < 512; k += 4) { const f32x4 xv = *(const f32x4*)(xr + k); const float* wp = rw + (size_t)(half * 512 + k) * 32 + e;
                acc += xv[0] * wp[0] + xv[1] * wp[32] + xv[2] * wp[64] + xv[3] * wp[96]; }
            acc += __shfl_xor(acc, 32);
            float val = acc + rb[e];
            float tv[4]; int ti[4];
#pragma unroll
            for (int r = 0; r < 4; ++r) {
                float best = val; int bi = e;
#pragma unroll
                for (int off = 16; off >= 1; off >>= 1) { const float ov = __shfl_xor(best, off); const int oi = __shfl_xor(bi, off); if (ov > best || (ov == best && oi < bi)) { best = ov; bi = oi; } }
                tv[r] = best; ti[r] = bi; if (e == bi) val = -3.0e38f;
            }
            const float e1 = __expf(tv[1] - tv[0]), e2 = __expf(tv[2] - tv[0]), e3 = __expf(tv[3] - tv[0]); const float inv = 1.0f / (1.0f + e1 + e2 + e3);
            if (lane == 0) {
                TOKE[t * 4 + 0] = ti[0]; TOKE[t * 4 + 1] = ti[1]; TOKE[t * 4 + 2] = ti[2]; TOKE[t * 4 + 3] = ti[3];
                TOKG[t * 4 + 0] = inv; TOKG[t * 4 + 1] = e1 * inv; TOKG[t * 4 + 2] = e2 * inv; TOKG[t * 4 + 3] = e3 * inv;
                atomicAdd((int*)(hist + ti[0]), 1); atomicAdd((int*)(hist + ti[1]), 1); atomicAdd((int*)(hist + ti[2]), 1); atomicAdd((int*)(hist + ti[3]), 1);
            }
        }
        __syncthreads();
        if (C.tid < 32) HIST[chunk * 32 + C.tid] = hist[C.tid];
        __syncthreads();
    }
}
DI void phase_moe_scatter(const Ctx& C, int layer) {
    const int lane = C.lane, tid = C.tid;
    unsigned char* tab = C.ws + WS_MOETAB + (size_t)layer * 2 * MiB;
    const int* TOKE = (const int*)(tab + MT_TOKE); int* TOKSLOT = (int*)(tab + MT_TOKSLOT); const int* HIST = (const int*)(tab + MT_HIST); int* TILEE = (int*)(tab + MT_TILEE);
    const bf16* XB = WSP(bf16, WS_XB); bf16* XG = WSP(bf16, R_XG);
    LAS int* tot = (LAS int*)(C.lds + 8 * 16384);
    LAS int* ebase = tot + 32;
    LAS int* cntl = tot + 96;
    LAS int* slots = tot + 128;
    if (tid < 32) { int s = 0; for (int c = 0; c < 256; ++c) s += HIST[c * 32 + tid]; tot[tid] = s; }
    __syncthreads();
    if (tid == 0) { int acc = 0; for (int e = 0; e < 32; ++e) { ebase[e] = acc; acc += (tot[e] + 255) & ~255; } ebase[32] = acc; }
    __syncthreads();
    if (C.bid == 0) { const int nmt = ebase[32] >> 8; for (int mt = tid; mt < nmt; mt += NTHREADS) { int e = 0; while (e < 31 && (mt << 8) >= ebase[e + 1]) ++e; TILEE[mt] = e; } if (tid == 0) TILEE[1023] = nmt; }
    for (int e = C.bid; e < 32; e += C.G) { const int r0 = ebase[e] + tot[e], r1 = ebase[e + 1];
        for (int r = r0 + C.wave; r < r1; r += NWAVES) { u32x4* p = (u32x4*)(XG + (size_t)r * 1024); p[lane] = (u32x4){0u, 0u, 0u, 0u}; p[lane + 64] = (u32x4){0u, 0u, 0u, 0u}; } }
    for (int chunk = C.bid; chunk < 256; chunk += C.G) {
        __syncthreads();
        if (tid < 32) { int s = ebase[tid]; for (int c = 0; c < chunk; ++c) s += HIST[c * 32 + tid]; cntl[tid] = s; }
        __syncthreads();
        if (C.wave == 0) {
            for (int bt = 0; bt < 8; ++bt) {
                const int idx = bt * 64 + lane; const int my_e = TOKE[(size_t)chunk * 512 + idx];
                int slot = 0;
                for (int e = 0; e < 32; ++e) { const u64 mm = __ballot(my_e == e); if (mm) { const int base = cntl[e]; if (my_e == e) slot = base + __popcll(mm & ((1ull << lane) - 1ull)); LDS_WAIT(); if (lane == 0) cntl[e] = base + __popcll(mm); LDS_WAIT(); } }
                slots[idx] = slot; TOKSLOT[(size_t)chunk * 512 + idx] = slot;
            }
        }
        __syncthreads();
        for (int i = C.wave; i < 512; i += NWAVES) { const int t = chunk * 128 + (i >> 2); const int slot = slots[i];
            const u32x4* src = (const u32x4*)(XB + (size_t)t * 1024); u32x4* dst = (u32x4*)(XG + (size_t)slot * 1024);
            dst[lane] = src[lane]; dst[lane + 64] = src[lane + 64]; }
    }
}
DI void phase_moe_combine_ln(const Ctx& C, int layer, const float* xprev, const float* gam, const float* bet, float* xnext, bf16* xb) {
    unsigned char* tab = C.ws + WS_MOETAB + (size_t)layer * 2 * MiB;
    const float* TOKG = (const float*)(tab + MT_TOKG); const int* TOKSLOT = (const int*)(tab + MT_TOKSLOT); const bf16* YEXP = WSP(bf16, R_YEXP);
    for (int t = C.gw; t < T; t += C.NGW) {
        f32x4 v[4];
#pragma unroll
        for (int j = 0; j < 4; ++j) v[j] = ((const f32x4*)(xprev + (size_t)t * DM))[C.lane + 64 * j] * ALPHA;
#pragma unroll
        for (int r = 0; r < 4; ++r) { const float gt = TOKG[t * 4 + r]; const int slot = TOKSLOT[t * 4 + r]; const u32x2* yr = (const u32x2*)(YEXP + (size_t)slot * 1024);
#pragma unroll
            for (int j = 0; j < 4; ++j) { const u32x2 w = yr[C.lane + 64 * j];
                v[j][0] += gt * __uint_as_float(w.x << 16); v[j][1] += gt * __uint_as_float(w.x & 0xffff0000u); v[j][2] += gt * __uint_as_float(w.y << 16); v[j][3] += gt * __uint_as_float(w.y & 0xffff0000u); } }
        ln_row_finish(v, gam, bet, xnext + (size_t)t * DM, xb + (size_t)t * DM, C.lane);
    }
}

DI void phase_hgrn_prep(const Ctx& C) {
    const int lane = C.lane; const bf16* PROJ = WSP(bf16, R_PROJ); float* F = WSP(float, R_FBUF); bf16* MIXIN = WSP(bf16, WS_MIXIN);
    const float* lbl = INP(float, 13); const float* cw = INP(float, 15); const float* cb = INP(float, 16);
    for (int t = C.gw; t < T; t += C.NGW) {
        const int s = t % SEQ; const bf16* pr = PROJ + (size_t)t * ODD_IN;
#pragma unroll
        for (int j = 0; j < 8; ++j) {
            const int c = lane + 64 * j;
            const float l0 = lbl[c], l1 = lbl[512 + c]; const float lb = 1.0f / (1.0f + __expf(l0 - l1));
            F[(size_t)t * 512 + c] = lb + (1.0f - lb) * sigmoidf(bf2f(pr[512 + c]));
            const float z0 = bf2f(pr[3072 + c]) * bf2f(pr[2048 + c]);
            const float z1 = s >= 1 ? bf2f(pr[3072 + c - ODD_IN]) * bf2f(pr[2048 + c - ODD_IN]) : 0.f;
            const float z2 = s >= 2 ? bf2f(pr[3072 + c - 2 * ODD_IN]) * bf2f(pr[2048 + c - 2 * ODD_IN]) : 0.f;
            const float y = cw[c] * z2 + cw[512 + c] * z1 + cw[1024 + c] * z0 + cb[c];
            MIXIN[(size_t)t * 1024 + 512 + c] = (bf16)f2bf(bf2f(pr[2560 + c]) * y);
        }
    }
}
DI void phase_hgrn_scan(const Ctx& C) {
    const int lane = C.lane, kq = lane >> 4, vv = lane & 15, v = C.wave * 16 + vv;
    const bf16* PROJ = WSP(bf16, R_PROJ); const float* F = WSP(float, R_FBUF); float* ORAW = WSP(float, R_ORAW);
    for (int bh = C.bid; bh < 32; bh += C.G) {
        const int b = bh >> 2, h = bh & 3;
        float S[32];
#pragma unroll
        for (int j = 0; j < 32; ++j) S[j] = 0.f;
        for (int s = 0; s < SEQ; ++s) {
            const size_t t = (size_t)b * SEQ + s;
            const float* fp = F + t * 512 + h * 128 + kq * 32; const bf16* qp = PROJ + t * ODD_IN + h * 128 + kq * 32;
            const float iv = bf2f(PROJ[t * ODD_IN + 1024 + h * 128 + v]);
            float o = 0.f;
#pragma unroll
            for (int j8 = 0; j8 < 4; ++j8) {
                const f32x4 f0 = *(const f32x4*)(fp + 8 * j8), f1 = *(const f32x4*)(fp + 8 * j8 + 4); const bf16x8 q8 = *(const bf16x8*)(qp + 8 * j8);
#pragma unroll
                for (int e = 0; e < 8; ++e) { const float f = e < 4 ? f0[e] : f1[e - 4]; const int j = 8 * j8 + e; S[j] = f * S[j] + (1.0f - f) * iv; o += bf2f((bf16)q8[e]) * S[j]; }
            }
            o += __shfl_xor(o, 16); o += __shfl_xor(o, 32);
            if (kq == 0) ORAW[t * 512 + h * 128 + v] = o;
        }
    }
}
DI void phase_hgrn_norm(const Ctx& C) {
    const int lane = C.lane; const bf16* PROJ = WSP(bf16, R_PROJ); const float* ORAW = WSP(float, R_ORAW); bf16* MIXIN = WSP(bf16, WS_MIXIN); const float* ng = INP(float, 14);
    for (int it0 = C.gw; it0 < T * 4; it0 += C.NGW) {
        const int it = __builtin_amdgcn_readfirstlane(it0); const int h = it & 3; const size_t t = it >> 2;
        const float o0 = ORAW[t * 512 + h * 128 + lane], o1 = ORAW[t * 512 + h * 128 + 64 + lane];
        const float ms = wave_sum(o0 * o0 + o1 * o1) * (1.0f / 128.0f); const float r = 1.0f / sqrtf(ms + 1e-6f);
        const float g0 = bf2f(PROJ[t * ODD_IN + 1536 + h * 128 + lane]), g1 = bf2f(PROJ[t * ODD_IN + 1536 + h * 128 + 64 + lane]);
        MIXIN[t * 1024 + h * 128 + lane] = (bf16)f2bf(o0 * r * ng[h * 128 + lane] * (g0 * sigmoidf(g0)));
        MIXIN[t * 1024 + h * 128 + 64 + lane] = (bf16)f2bf(o1 * r * ng[h * 128 + 64 + lane] * (g1 * sigmoidf(g1)));
    }
}

DI void gemm_bf16out(const Ctx& C, const bf16* A, const bf16* Bt, int M, int N, bf16* O, int ldc) {
    pg8::DenseOrder S; S.init(A, 1024, Bt, 1024, M, N, C.G, C.bid);
    pg8::EpiBf16 E{O, ldc, nullptr, 0};
    pg8::gemm_phase<pg8::EpiBf16, pg8::DenseOrder>(C.lds, 1024, 1024, 1024, S, E);
}
DI void gemm_f32out(const Ctx& C, const bf16* A, const bf16* Bt, int M, int N, float* O, int ldc) {
    pg8::DenseOrder S; S.init(A, 1024, Bt, 1024, M, N, C.G, C.bid);
    pg8::EpiF32 E{O, ldc};
    pg8::gemm_phase<pg8::EpiF32, pg8::DenseOrder>(C.lds, 1024, 1024, 1024, S, E);
}
DI void gemm_moe_gu(const Ctx& C, int layer) {
    unsigned char* tab = C.ws + WS_MOETAB + (size_t)layer * 2 * MiB; const int* TILEE = (const int*)(tab + MT_TILEE);
    const int nmt = (int)__hip_atomic_load((const unsigned*)TILEE + 1023, __ATOMIC_RELAXED, __HIP_MEMORY_SCOPE_AGENT);
    pg8::MoeOrder S; S.init(WSP(bf16, R_XG), WSP(bf16, WS_WGU) + (size_t)layer * 32 * 2048 * 1024, 2048, TILEE, nmt, C.G, C.bid);
    pg8::EpiSwiglu E{WSP(bf16, R_ACT), INP(float, 26) + (size_t)layer * 32 * 2048};
    pg8::gemm_phase<pg8::EpiSwiglu, pg8::MoeOrder>(C.lds, 1024, 1024, 1024, S, E);
}
DI void gemm_moe_dn(const Ctx& C, int layer) {
    unsigned char* tab = C.ws + WS_MOETAB + (size_t)layer * 2 * MiB; const int* TILEE = (const int*)(tab + MT_TILEE);
    const int nmt = (int)__hip_atomic_load((const unsigned*)TILEE + 1023, __ATOMIC_RELAXED, __HIP_MEMORY_SCOPE_AGENT);
    pg8::MoeOrder S; S.init(WSP(bf16, R_ACT), WSP(bf16, WS_WDN) + (size_t)layer * 32 * 1024 * 1024, 1024, TILEE, nmt, C.G, C.bid);
    pg8::EpiBf16 E{WSP(bf16, R_YEXP), 1024, INP(float, 28) + (size_t)layer * 32 * 1024, 1024};
    pg8::gemm_phase<pg8::EpiBf16, pg8::MoeOrder>(C.lds, 1024, 1024, 1024, S, E);
}

constexpr int N_PHASES = 33;
__global__ void __launch_bounds__(NTHREADS, 2) mega(Args args) {
    extern __shared__ __attribute__((aligned(16))) unsigned char lds_raw[];
    Ctx C;
    C.lds = (LAS unsigned char*)lds_raw; C.ws = args.ws; C.a = &args;
    C.tid = threadIdx.x; C.lane = C.tid & 63; C.wave = __builtin_amdgcn_readfirstlane(C.tid >> 6); C.bid = blockIdx.x; C.G = gridDim.x;
    C.gw = C.bid * NWAVES + C.wave; C.NGW = C.G * NWAVES;
    volatile LAS unsigned* MISC = (volatile LAS unsigned*)(C.lds + LDSCTL_OFF);
    for (int u = C.tid; u < (LDS_BYTES - LDSCTL_OFF) / 4; u += NTHREADS) MISC[u] = 0u;
    __syncthreads();
    const int lo = args.ph_lo, hi = args.ph_hi;
    XcdBarrier bar; bar.bar = (unsigned*)(C.ws + WS_CTL) + CW_BAR; bar.x = 0; bar.st = nullptr;
    if (hi - lo > 1) bar = xcd_barrier_post((unsigned*)(C.ws + WS_CTL) + CW_BAR, MISC + 8);
#ifndef PHMASK
#define PHMASK 0x1ffffffffull
#endif
#define IN(k) ((((PHMASK) >> (k)) & 1ull) && lo <= (k) && (k) < hi)
#define SEAM(k) do { if (IN(k) && IN((k) + 1)) xcd_barrier(bar); } while (0)
    const float* lng = INP(float, 21); const float* lnb = INP(float, 22);
    float* XA = WSP(float, WS_XA); float* XBF = WSP(float, WS_XBF); bf16* XB = WSP(bf16, WS_XB);

    if (IN(0)) { phase_convert(C); } SEAM(0);
    if (IN(1)) {
        gemm_bf16out(C, XB, WSP(bf16, WS_WEVEN), T, EVEN_PAD, WSP(bf16, R_PROJ), EVEN_PAD);
        gemm_bf16out(C, WSP(bf16, WS_MEMB), WSP(bf16, WS_WXKV), 2048, 2048, WSP(bf16, WS_XKV), 2048);
        gemm_bf16out(C, WSP(bf16, WS_MEMB), WSP(bf16, WS_WXKV) + (size_t)2048 * 1024, 2048, 2048, WSP(bf16, WS_XKV) + (size_t)2048 * 2048, 2048);
    } SEAM(1);
    if (IN(2)) { phase_nsa_prep(C); } SEAM(2);
    if (IN(3)) { phase_cmp_hidden(C); } SEAM(3);
    if (IN(4)) { phase_cmp_out(C); } SEAM(4);
    if (IN(5)) { phase_cmp_attn(C); } SEAM(5);
    if (IN(6)) { phase_slc_win_sgu(C); } SEAM(6);
    if (IN(7)) { gemm_f32out(C, WSP(bf16, WS_MIXIN), WSP(bf16, WS_WOUTE), T, 1024, WSP(float, WS_YBUF), 1024); } SEAM(7);
    if (IN(8)) { phase_ln(C, INP(float, 0), WSP(float, WS_YBUF), lng + 0 * 1024, lnb + 0 * 1024, XA, XB); } SEAM(8);
    if (IN(9)) { gemm_bf16out(C, XB, WSP(bf16, WS_WXQ), T, 1024, WSP(bf16, WS_XQ), 1024); } SEAM(9);
    if (IN(10)) { phase_xattn(C, 0); } SEAM(10);
    if (IN(11)) { gemm_f32out(C, WSP(bf16, WS_XO), WSP(bf16, WS_WXO), T, 1024, WSP(float, WS_YBUF), 1024); } SEAM(11);
    if (IN(12)) { phase_ln(C, XA, WSP(float, WS_YBUF), lng + 1 * 1024, lnb + 1 * 1024, XBF, XB); } SEAM(12);
    if (IN(13)) { phase_router(C, 0, XBF); } SEAM(13);
    if (IN(14)) { phase_moe_scatter(C, 0); } SEAM(14);
    if (IN(15)) { gemm_moe_gu(C, 0); } SEAM(15);
    if (IN(16)) { gemm_moe_dn(C, 0); } SEAM(16);
    if (IN(17)) { phase_moe_combine_ln(C, 0, XBF, lng + 2 * 1024, lnb + 2 * 1024, XA, XB); } SEAM(17);
    if (IN(18)) { gemm_bf16out(C, XB, WSP(bf16, WS_WODD), T, ODD_IN, WSP(bf16, R_PROJ), ODD_IN); } SEAM(18);
    if (IN(19)) { phase_hgrn_prep(C); } SEAM(19);
    if (IN(20)) { phase_hgrn_scan(C); } SEAM(20);
    if (IN(21)) { phase_hgrn_norm(C); } SEAM(21);
    if (IN(22)) { gemm_f32out(C, WSP(bf16, WS_MIXIN), WSP(bf16, WS_WOUTO), T, 1024, WSP(float, WS_YBUF), 1024); } SEAM(22);
    if (IN(23)) { phase_ln(C, XA, WSP(float, WS_YBUF), lng + 3 * 1024, lnb + 3 * 1024, XBF, XB); } SEAM(23);
    if (IN(24)) { gemm_bf16out(C, XB, WSP(bf16, WS_WXQ) + (size_t)1024 * 1024, T, 1024, WSP(bf16, WS_XQ), 1024); } SEAM(24);
    if (IN(25)) { phase_xattn(C, 1); } SEAM(25);
    if (IN(26)) { gemm_f32out(C, WSP(bf16, WS_XO), WSP(bf16, WS_WXO) + (size_t)1024 * 1024, T, 1024, WSP(float, WS_YBUF), 1024); } SEAM(26);
    if (IN(27)) { phase_ln(C, XBF, WSP(float, WS_YBUF), lng + 4 * 1024, lnb + 4 * 1024, XA, XB); } SEAM(27);
    if (IN(28)) { phase_router(C, 1, XA); } SEAM(28);
    if (IN(29)) { phase_moe_scatter(C, 1); } SEAM(29);
    if (IN(30)) { gemm_moe_gu(C, 1); } SEAM(30);
    if (IN(31)) { gemm_moe_dn(C, 1); } SEAM(31);
    if (IN(32)) { phase_moe_combine_ln(C, 1, XA, lng + 5 * 1024, lnb + 5 * 1024, args.out, XB); }
}

extern "C" void kernel_launch(void* const* d_in, const int* in_sizes, int n_in, void* d_out, int out_size, void* d_ws, size_t ws_size, hipStream_t stream) {
    static int grid = 0;
    if (grid == 0) {
        if (n_in != 29 || ws_size < WS_END) { fprintf(stderr, "kernel_launch: unexpected n_in %d / ws_size %zu (need %zu)\n", n_in, ws_size, (size_t)WS_END); grid = -1; return; }
        int dev = 0, cus = 0, per_cu = 0;
        hipGetDevice(&dev); hipDeviceGetAttribute(&cus, hipDeviceAttributeMultiprocessorCount, dev);
        if (hipFuncSetAttribute((const void*)mega, hipFuncAttributeMaxDynamicSharedMemorySize, LDS_BYTES) != hipSuccess) { fprintf(stderr, "kernel_launch: hipFuncSetAttribute failed\n"); grid = -1; return; }
        hipOccupancyMaxActiveBlocksPerMultiprocessor(&per_cu, (const void*)mega, NTHREADS, LDS_BYTES);
        if (per_cu < 1) fprintf(stderr, "kernel_launch: occupancy query says %d\n", per_cu);
        grid = cus > 0 ? cus : 256;
    }
    if (grid < 0) return;
    hipMemsetAsync((char*)d_ws + WS_CTL, 0, CTL_BYTES, stream);
    Args a{};
    for (int i = 0; i < 29; ++i) a.in[i] = d_in[i];
    a.out = (float*)d_out; a.ws = (unsigned char*)d_ws;
#if ONE_LAUNCH
    a.ph_lo = 0; a.ph_hi = N_PHASES;
    hipLaunchKernelGGL(mega, dim3(grid), dim3(NTHREADS), LDS_BYTES, stream, a);
#else
    for (int p = 0; p < N_PHASES; ++p) { a.ph_lo = p; a.ph_hi = p + 1; hipLaunchKernelGGL(mega, dim3(grid), dim3(NTHREADS), LDS_BYTES, stream, a); }
#endif
}
```

```cpp
#include <hip/hip_runtime.h>
#include <cstdio>
#include <cstdint>

#ifndef ONE_LAUNCH
#define ONE_LAUNCH 1
#endif

#define LAS __attribute__((address_space(3)))
#define DI __device__ __forceinline__
typedef unsigned short bf16;
typedef short bf16x8 __attribute__((ext_vector_type(8)));
typedef float f32x4 __attribute__((ext_vector_type(4)));
typedef float f32x2 __attribute__((ext_vector_type(2)));
typedef unsigned u32x4 __attribute__((ext_vector_type(4)));
typedef unsigned u32x2 __attribute__((ext_vector_type(2)));
typedef unsigned long long u64;

constexpr int NB = 8, SEQ = 4096, T = NB * SEQ, DM = 1024;
constexpr int EVEN_IN = 2328, EVEN_PAD = 2560, ODD_IN = 3584;
constexpr int NEXP = 32, TOPK = 4;
constexpr int XG_ROWS = T * TOPK + NEXP * 256;
constexpr float ALPHA = 1.41421356237f;
constexpr int NWAVES = 8, NTHREADS = 512;

constexpr size_t MiB = 1u << 20;
constexpr size_t WS_CTL = 0, CTL_BYTES = 1 * MiB;
constexpr size_t WS_WEVEN = 1 * MiB, WS_WODD = 6 * MiB, WS_WOUTE = 13 * MiB, WS_WOUTO = 15 * MiB, WS_WXQ = 17 * MiB, WS_WXKV = 21 * MiB, WS_WXO = 29 * MiB;
constexpr size_t WS_WGU = 33 * MiB, WS_WDN = 289 * MiB;
constexpr size_t WS_XB = 417 * MiB, WS_MEMB = 481 * MiB, WS_ROPEC = 485 * MiB, WS_ROPES = 489 * MiB;
constexpr size_t WS_MIXIN = 493 * MiB, WS_YBUF = 557 * MiB, WS_XA = 685 * MiB, WS_XBF = 813 * MiB;
constexpr size_t WS_XKV = 941 * MiB, WS_XQ = 957 * MiB, WS_XO = 1021 * MiB, WS_MOETAB = 1085 * MiB, WS_R1 = 1089 * MiB, WS_END = 1905 * MiB;
constexpr size_t R_PROJ = WS_R1, R_QN = WS_R1 + 224 * MiB, R_QR = WS_R1 + 256 * MiB, R_KCMP = WS_R1 + 288 * MiB, R_VCMP = WS_R1 + 297 * MiB;
constexpr size_t R_KSLC = WS_R1 + 306 * MiB, R_VSLC = WS_R1 + 314 * MiB, R_KWIN = WS_R1 + 322 * MiB, R_VWIN = WS_R1 + 330 * MiB;
constexpr size_t R_GATES = WS_R1 + 338 * MiB, R_UG = WS_R1 + 341 * MiB, R_VN = WS_R1 + 373 * MiB, R_H1 = WS_R1 + 405 * MiB;
constexpr size_t R_KC = WS_R1 + 413 * MiB, R_VC = WS_R1 + 414 * MiB, R_SELM = WS_R1 + 415 * MiB, R_OCMP = WS_R1 + 416 * MiB;
constexpr size_t R_FBUF = WS_R1 + 480 * MiB, R_ORAW = WS_R1 + 544 * MiB;
constexpr size_t R_XG = WS_R1, R_ACT = WS_R1 + 272 * MiB, R_YEXP = WS_R1 + 544 * MiB;
constexpr size_t MT_TOKE = 0, MT_TOKG = 512 * 1024, MT_TOKSLOT = 1024 * 1024, MT_HIST = 1536 * 1024, MT_TILEE = 1536 * 1024 + 64 * 1024;
constexpr int CW_BAR = 4096;

constexpr int STAGE_BYTES_LDS = 131072, LDSCTL_OFF = 131072, LDS_BYTES = 147456;

DI float bf2f(bf16 v) { return __uint_as_float(((unsigned)v) << 16); }
DI unsigned f2bf(float f) { unsigned u = __float_as_uint(f); return (u + 0x7fffu + ((u >> 16) & 1u)) >> 16; }
DI unsigned pk2(float lo, float hi) { return f2bf(lo) | (f2bf(hi) << 16); }
DI float wave_sum(float v) {
#pragma unroll
    for (int o = 1; o < 64; o <<= 1) v += __shfl_xor(v, o);
    return v;
}
DI float wave_max(float v) {
#pragma unroll
    for (int o = 1; o < 64; o <<= 1) v = fmaxf(v, __shfl_xor(v, o));
    return v;
}
DI float rdlane(float x, int i) { return __builtin_bit_cast(float, __builtin_amdgcn_readlane(__builtin_bit_cast(int, x), i)); }
DI float gelu_tanh(float x) { const float u = 0.7978845608028654f * (x + 0.044715f * x * x * x); return 0.5f * x * (1.0f + tanhf(u)); }
DI float sigmoidf(float x) { return 1.0f / (1.0f + __expf(-x)); }
#define LDS_WAIT() asm volatile("s_waitcnt lgkmcnt(0)" ::: "memory")

#define XB_TMO      128
#define XB_XCNT(j)  (256  + 64 * (j))
#define XB_XSUB(j)  (1280 + 64 * (j))
#define XB_XGEN(j)  (2304 + 64 * (j))
#define XB_TOP      3328
#define XB_TOPGEN   3392
#define XCD_BAR_WORDS 3456
#define XB_SPIN_CAP (1u << 18)
__device__ __forceinline__ unsigned xb_ld(unsigned* p)              { return __hip_atomic_load(p, __ATOMIC_RELAXED, __HIP_MEMORY_SCOPE_AGENT); }
__device__ __forceinline__ unsigned xb_add(unsigned* p, unsigned v) { return __hip_atomic_fetch_add(p, v, __ATOMIC_RELAXED, __HIP_MEMORY_SCOPE_AGENT); }
__device__ __forceinline__ unsigned xb_xcc_id() { return (unsigned)__builtin_amdgcn_s_getreg((3 << 11) | 20) & 0xFu; }
#define XB_SPIN(cond, bar) do { unsigned _sp = 0; while (cond) { __builtin_amdgcn_s_sleep(1); \
    if ((++_sp & 255u) == 0u) { if (xb_ld(&(bar)[XB_TMO])) break; if (_sp > XB_SPIN_CAP) { atomicAdd(&(bar)[XB_TMO], 1u); break; } } } } while (0)
struct XcdBarrier { unsigned* bar; unsigned x; volatile LAS unsigned* st; };
__device__ __forceinline__ XcdBarrier xcd_barrier_post(unsigned* bar, volatile LAS unsigned* st) {
    XcdBarrier b; b.bar = bar; b.x = xb_xcc_id(); b.st = st;
    if (threadIdx.x == 0) (void)xb_add(&bar[XB_XCNT(b.x)], 1u);
    return b;
}
__device__ __forceinline__ void xcd_barrier_complete(unsigned* bar, unsigned x, unsigned& nloc, unsigned& nx) {
    const unsigned G = gridDim.x * gridDim.y * gridDim.z;
    unsigned sum, cnt, mine, sp = 0u;
    for (;;) {
        sum = 0u; cnt = 0u; mine = 0u;
#pragma unroll
        for (unsigned j = 0; j < 16; ++j) { const unsigned c = xb_ld(&bar[XB_XCNT(j)]); sum += c; cnt += (c > 0u) ? 1u : 0u; mine = (j == x) ? c : mine; }
        if (sum == G) break;
        __builtin_amdgcn_s_sleep(1);
        if ((++sp & 255u) == 0u) { if (xb_ld(&bar[XB_TMO])) break; if (sp > XB_SPIN_CAP) { atomicAdd(&bar[XB_TMO], 1u); break; } }
    }
    nloc = mine > 0u ? mine : 1u; nx = cnt > 0u ? cnt : 1u;
}
__device__ __forceinline__ void xcd_barrier(const XcdBarrier& b) {
    asm volatile("s_waitcnt vmcnt(0)" ::: "memory");
    __syncthreads();
    if (threadIdx.x == 0) {
        unsigned* bar = b.bar;
        __builtin_amdgcn_s_waitcnt(0);
        unsigned nloc = b.st[0], nx = b.st[1];
        if (nloc == 0u) { xcd_barrier_complete(bar, b.x, nloc, nx); b.st[0] = nloc; b.st[1] = nx; }
        const unsigned old = xb_add(&bar[XB_XSUB(b.x)], 1u);
        const unsigned gen = old / nloc;
        if (old + 1u == (gen + 1u) * nloc) {
            __builtin_amdgcn_fence(__ATOMIC_RELEASE, "agent");
            asm volatile("s_waitcnt vmcnt(0)" ::: "memory");
            const unsigned og = xb_add(&bar[XB_TOP], 1u);
            const unsigned tg = og / nx;
            if (og + 1u == (tg + 1u) * nx) xb_add(&bar[XB_TOPGEN], 1u);
            else XB_SPIN(xb_ld(&bar[XB_TOPGEN]) == tg, bar);
            __builtin_amdgcn_fence(__ATOMIC_ACQUIRE, "agent");
            xb_add(&bar[XB_XGEN(b.x)], 1u);
            asm volatile("s_waitcnt vmcnt(0)" ::: "memory");
        } else {
            XB_SPIN(xb_ld(&bar[XB_XGEN(b.x)]) == gen, bar);
            __builtin_amdgcn_fence(__ATOMIC_ACQUIRE, "agent");
            asm volatile("s_waitcnt vmcnt(0)" ::: "memory");
        }
    }
    __syncthreads();
}

namespace pg8 {
constexpr int BM = 256, BK = 64, HALF = 128, HTB = HALF * BK * 2, STAGE_BYTES = 8 * HTB, NXCD = 8, WGM = 8;
DI int lds_byte(int r, int c) { const int st = (r >> 4) * 2 + (c >> 5), rr = r & 15, cc = c & 31, ob = rr * 64 + cc * 2; return st * 1024 + (ob ^ (((ob >> 9) & 1) << 5)); }
DI void stage_rc(int b, int& R, int& C) { const int st = b / 1024, sb = b % 1024, swz = sb ^ (((sb >> 9) & 1) << 5); R = (st >> 1) * 16 + swz / 64; C = (st & 1) * 32 + (swz % 64) / 2; }
DI int perm32(int rho) { const int n = rho >> 4, i = rho & 15; return 8 * (i >> 2) + 4 * n + (i & 3); }

struct Unit { int pm, pn, e; const char* A; const char* B; };

struct DenseOrder {
    int nM, nN, nwg, G, c; const char* A; const char* Bt; size_t tstepA, tstepB;
    DI void init(const bf16* A_, int lda, const bf16* Bt_, int ldb, int M, int N, int G_, int c_) { nM = M / BM; nN = N / BM; nwg = nM * nN; G = G_; c = c_; A = (const char*)A_; Bt = (const char*)Bt_; tstepA = (size_t)BM * lda * 2; tstepB = (size_t)BM * ldb * 2; }
    DI bool next(int i, Unit& u) const {
        const long L = (long)i * G + c; if (L >= nwg) return false;
        int wgid = (int)L; { const int q = nwg / NXCD, r = nwg % NXCD, xcd = wgid % NXCD, off = wgid / NXCD; wgid = (xcd < r ? xcd * (q + 1) : r * (q + 1) + (xcd - r) * q) + off; }
        const int nig = WGM * nN, gid = wgid / nig, fm = gid * WGM, gsz = (nM - fm) < WGM ? (nM - fm) : WGM;
        u.pm = fm + ((wgid % nig) % gsz); u.pn = (wgid % nig) / gsz; u.e = 0;
        u.A = A + (size_t)u.pm * tstepA; u.B = Bt + (size_t)u.pn * tstepB; return true;
    }
};
struct MoeOrder {
    int nN, nunits, G, c; const char* A; const char* W; size_t estride; const int* tile_e;
    DI void init(const bf16* A_, const bf16* W_, int Nexp, const int* tile_e_, int nmt, int G_, int c_) { nN = Nexp / BM; nunits = nmt * nN; G = G_; c = c_; A = (const char*)A_; W = (const char*)W_; estride = (size_t)Nexp * 1024 * 2; tile_e = tile_e_; }
    DI bool next(int i, Unit& u) const {
        const long L = (long)i * G + c; if (L >= nunits) return false;
        const int l = (int)L; u.pm = l / nN; u.pn = l % nN;
        u.e = (int)__hip_atomic_load((const unsigned*)tile_e + u.pm, __ATOMIC_RELAXED, __HIP_MEMORY_SCOPE_AGENT) & 31;
        u.A = A + (size_t)u.pm * (BM * 1024 * 2); u.B = W + (size_t)u.e * estride + (size_t)u.pn * (BM * 1024 * 2); return true;
    }
};

DI unsigned cvt_pk_bf16(float lo, float hi) { unsigned r; asm volatile("v_cvt_pk_bf16_f32 %0, %1, %2" : "=v"(r) : "v"(lo), "v"(hi)); return r; }

struct EpiF32 {
    static constexpr bool PERM = false;
    float* C; int ldc;
    DI void operator()(const f32x4 (&acc)[2][2][4][2], const Unit& u, int wr, int wc, int fr, int fq) const {
        const int row0 = u.pm * BM + wr * 64 + fr, col0 = u.pn * BM + wc * 32 + 4 * fq;
#pragma unroll
        for (int ai = 0; ai < 2; ++ai)
#pragma unroll
            for (int m = 0; m < 4; ++m) { float* rowp = C + (size_t)(row0 + ai * HALF + m * 16) * ldc + col0;
#pragma unroll
                for (int bj = 0; bj < 2; ++bj)
#pragma unroll
                    for (int n = 0; n < 2; ++n) *(f32x4*)(rowp + bj * HALF + n * 16) = acc[ai][bj][m][n]; }
    }
};
struct EpiBf16 {
    static constexpr bool PERM = true;
    bf16* O; int ldc; const float* bias; int bias_estride;
    DI void operator()(const f32x4 (&acc)[2][2][4][2], const Unit& u, int wr, int wc, int fr, int fq) const {
        const int row0 = u.pm * BM + wr * 64 + fr, col0 = u.pn * BM + wc * 32 + 8 * fq;
        f32x4 bv[2][2];
#pragma unroll
        for (int bj = 0; bj < 2; ++bj)
#pragma unroll
            for (int n = 0; n < 2; ++n) bv[bj][n] = bias ? *(const f32x4*)(bias + (size_t)u.e * bias_estride + col0 + bj * HALF + 4 * n) : (f32x4){0.f, 0.f, 0.f, 0.f};
#pragma unroll
        for (int ai = 0; ai < 2; ++ai)
#pragma unroll
            for (int m = 0; m < 4; ++m) { bf16* rowp = O + (size_t)(row0 + ai * HALF + m * 16) * ldc + col0;
#pragma unroll
                for (int bj = 0; bj < 2; ++bj) { const f32x4 v0 = acc[ai][bj][m][0] + bv[bj][0], v1 = acc[ai][bj][m][1] + bv[bj][1];
                    u32x4 w; w.x = cvt_pk_bf16(v0[0], v0[1]); w.y = cvt_pk_bf16(v0[2], v0[3]); w.z = cvt_pk_bf16(v1[0], v1[1]); w.w = cvt_pk_bf16(v1[2], v1[3]);
                    *(u32x4*)(rowp + bj * HALF) = w; } }
    }
};
struct EpiSwiglu {
    static constexpr bool PERM = true;
    bf16* O; const float* bias;
    DI void operator()(const f32x4 (&acc)[2][2][4][2], const Unit& u, int wr, int wc, int fr, int fq) const {
        const int row0 = u.pm * BM + wr * 64 + fr, cw = u.pn * HALF + wc * 32 + 8 * fq;
        const float* bb = bias + (size_t)u.e * 2048 + cw;
        f32x4 bg[2], bu[2];
#pragma unroll
        for (int n = 0; n < 2; ++n) { bg[n] = *(const f32x4*)(bb + 4 * n); bu[n] = *(const f32x4*)(bb + 1024 + 4 * n); }
#pragma unroll
        for (int ai = 0; ai < 2; ++ai)
#pragma unroll
            for (int m = 0; m < 4; ++m) {
                float r[8];
#pragma unroll
                for (int n = 0; n < 2; ++n)
#pragma unroll
                    for (int j = 0; j < 4; ++j) {
                        const float g = fminf(acc[ai][0][m][n][j] + bg[n][j], 7.0f);
                        const float up = fminf(fmaxf(acc[ai][1][m][n][j] + bu[n][j], -7.0f), 7.0f);
                        r[n * 4 + j] = (up + 1.0f) * (g / (1.0f + __expf(-1.702f * g)));
                    }
                u32x4 w; w.x = cvt_pk_bf16(r[0], r[1]); w.y = cvt_pk_bf16(r[2], r[3]); w.z = cvt_pk_bf16(r[4], r[5]); w.w = cvt_pk_bf16(r[6], r[7]);
                *(u32x4*)(O + (size_t)(row0 + ai * HALF + m * 16) * 1024 + cw) = w;
            }
    }
};

template <class Epi, class Sched>
DI void gemm_phase(LAS unsigned char* lds, const int lda, const int ldb, const int K, const Sched& S, const Epi& E) {
    const int tid = threadIdx.x, wid = __builtin_amdgcn_readfirstlane(tid >> 6), lane = tid & 63, wr = wid >> 2, wc = wid & 3, fr = lane & 15, fq = lane >> 4;
    const int nt = K / BK;
    unsigned voffA[2], voffB[2];
#pragma unroll
    for (int i = 0; i < 2; ++i) { int R, C; stage_rc(tid * 16 + i * 8192, R, C); const int Rb = Epi::PERM ? ((R & ~31) + perm32(R & 31)) : R;
        voffA[i] = (unsigned)(R * lda + C) * 2u; voffB[i] = (unsigned)(Rb * ldb + C) * 2u; }
    const size_t kstep = (size_t)(BK * 2);
    const size_t hstepA = (size_t)HALF * lda * 2, hstepB = (size_t)HALF * ldb * 2;
    const unsigned ldsw = (unsigned)wid * 1024u;
    const int aoff = lds_byte(wr * 64 + fr, fq * 8), boff = lds_byte(wc * 32 + fr, fq * 8);
#define PG8_SA(b, h) (((b) * 2 + (h)) * HTB)
#define PG8_SB(b, h) ((4 + (b) * 2 + (h)) * HTB)
#define PG8_STAGE(bufoff, gbase, voff) do { _Pragma("unroll") for (int _i = 0; _i < 2; ++_i) \
        __builtin_amdgcn_global_load_lds((const unsigned*)((const char*)(gbase) + (voff)[_i]), (LAS unsigned*)(lds + (bufoff) + ldsw + _i * 8192), 16, 0, 0); } while (0)
#define PG8_LDA(dst, b, h) do { _Pragma("unroll") for (int m = 0; m < 4; ++m) _Pragma("unroll") for (int k = 0; k < 2; ++k) dst[m][k] = *(const LAS bf16x8*)(lds + PG8_SA(b, h) + aoff + m * 2048 + k * 1024); } while (0)
#define PG8_LDB(dst, b, h) do { _Pragma("unroll") for (int n = 0; n < 2; ++n) _Pragma("unroll") for (int k = 0; k < 2; ++k) dst[n][k] = *(const LAS bf16x8*)(lds + PG8_SB(b, h) + boff + n * 2048 + k * 1024); } while (0)
#define PG8_MMA(ai, bj, At, Bt) do { __builtin_amdgcn_s_setprio(1); _Pragma("unroll") for (int m = 0; m < 4; ++m) _Pragma("unroll") for (int n = 0; n < 2; ++n) _Pragma("unroll") for (int k = 0; k < 2; ++k) \
        acc[ai][bj][m][n] = __builtin_amdgcn_mfma_f32_16x16x32_bf16(Bt[n][k], At[m][k], acc[ai][bj][m][n], 0, 0, 0); __builtin_amdgcn_s_setprio(0); } while (0)
#define PG8_WAIT_V(n) asm volatile("s_waitcnt vmcnt(" #n ")" ::: "memory")
#define PG8_WAIT_L(n) asm volatile("s_waitcnt lgkmcnt(" #n ")" ::: "memory")
#define PG8_BAR __builtin_amdgcn_s_barrier()
#define PG8_SCHED __builtin_amdgcn_sched_barrier(0)
    Unit cur, nxt; int ui = 0;
    if (!S.next(0, cur)) return;
    f32x4 acc[2][2][4][2];
#pragma unroll
    for (int a = 0; a < 2; ++a)
#pragma unroll
        for (int b = 0; b < 2; ++b)
#pragma unroll
            for (int m = 0; m < 4; ++m)
#pragma unroll
                for (int n = 0; n < 2; ++n) acc[a][b][m][n] = (f32x4){0.f, 0.f, 0.f, 0.f};
    bf16x8 At[4][2], B0[2][2], B1[2][2];
    const char* cA = cur.A; const char* cB = cur.B;
    PG8_STAGE(PG8_SB(0, 0), cB, voffB); PG8_STAGE(PG8_SA(0, 0), cA, voffA); PG8_STAGE(PG8_SB(0, 1), cB + hstepB, voffB); PG8_STAGE(PG8_SA(0, 1), cA + hstepA, voffA);
    if (wr == 1) PG8_BAR;
    PG8_WAIT_V(4); PG8_BAR;
    PG8_STAGE(PG8_SB(1, 0), cB + kstep, voffB); PG8_STAGE(PG8_SA(1, 0), cA + kstep, voffA); PG8_STAGE(PG8_SB(1, 1), cB + hstepB + kstep, voffB);
    PG8_WAIT_V(6); PG8_BAR;
    for (;;) {
        const bool has_next = S.next(ui + 1, nxt);
        const char* nA = has_next ? nxt.A : cA; const char* nB = has_next ? nxt.B : cB;
        for (int t = 0; t < nt; t += 2) {
            const bool last = (t == nt - 2);
            const char* a1 = cA + (size_t)(t + 1) * kstep;
            const char* a2 = last ? nA : cA + (size_t)(t + 2) * kstep; const char* b2 = last ? nB : cB + (size_t)(t + 2) * kstep;
            const char* a3 = a2 + kstep; const char* b3 = b2 + kstep;
            PG8_LDB(B0, 0, 0); PG8_SCHED; PG8_LDA(At, 0, 0); PG8_STAGE(PG8_SA(1, 1), a1 + hstepA, voffA);
            PG8_WAIT_L(8); PG8_BAR; PG8_WAIT_L(0); PG8_MMA(0, 0, At, B0); PG8_BAR; PG8_SCHED;
            PG8_LDB(B1, 0, 1); PG8_STAGE(PG8_SB(0, 0), b2, voffB);
            PG8_BAR; PG8_WAIT_L(0); PG8_MMA(0, 1, At, B1); PG8_BAR;
            PG8_LDA(At, 0, 1); PG8_STAGE(PG8_SA(0, 0), a2, voffA);
            PG8_BAR; PG8_WAIT_L(0); PG8_MMA(1, 0, At, B0); PG8_BAR; PG8_SCHED;
            PG8_STAGE(PG8_SB(0, 1), b2 + hstepB, voffB);
            PG8_WAIT_V(6); PG8_BAR; PG8_MMA(1, 1, At, B1); PG8_BAR;
            PG8_LDB(B0, 1, 0); PG8_SCHED; PG8_LDA(At, 1, 0); PG8_STAGE(PG8_SA(0, 1), a2 + hstepA, voffA);
            PG8_WAIT_L(8); PG8_BAR; PG8_WAIT_L(0); PG8_MMA(0, 0, At, B0); PG8_BAR; PG8_SCHED;
            PG8_LDB(B1, 1, 1); PG8_STAGE(PG8_SB(1, 0), b3, voffB);
            PG8_BAR; PG8_WAIT_L(0); PG8_MMA(0, 1, At, B1); PG8_BAR;
            PG8_LDA(At, 1, 1); PG8_STAGE(PG8_SA(1, 0), a3, voffA);
            PG8_BAR; PG8_WAIT_L(0); PG8_MMA(1, 0, At, B0); PG8_BAR; PG8_SCHED;
            PG8_STAGE(PG8_SB(1, 1), b3 + hstepB, voffB);
            PG8_WAIT_V(6); PG8_BAR; PG8_MMA(1, 1, At, B1); PG8_BAR;
        }
        E(acc, cur, wr, wc, fr, fq);
        if (!has_next) break;
#pragma unroll
        for (int a = 0; a < 2; ++a)
#pragma unroll
            for (int b = 0; b < 2; ++b)
#pragma unroll
                for (int m = 0; m < 4; ++m)
#pragma unroll
                    for (int n = 0; n < 2; ++n) acc[a][b][m][n] = (f32x4){0.f, 0.f, 0.f, 0.f};
        cur = nxt; cA = nA; cB = nB; ++ui;
    }
    PG8_WAIT_V(0);
    if (wr == 0) PG8_BAR;
    PG8_BAR;
#undef PG8_SA
#undef PG8_SB
#undef PG8_STAGE
#undef PG8_LDA
#undef PG8_LDB
#undef PG8_MMA
#undef PG8_WAIT_V
#undef PG8_WAIT_L
#undef PG8_BAR
#undef PG8_SCHED
}
}

struct Args { const void* in[29]; float* out; unsigned char* ws; int ph_lo, ph_hi; };

struct Ctx {
    LAS unsigned char* lds; unsigned char* ws; const Args* a;
    int tid, lane, wave, bid, G, gw, NGW;
};
#define WSP(type, off) ((type*)(C.ws + (off)))
#define INP(type, i) ((const type*)(C.a->in[i]))

DI void transpose_item(const float* W, int K, int N, int nblk, bf16* WT, int mode, LAS float* scr, int item, int lane) {
    const int kb = item / nblk, nb = item % nblk, k0 = 64 * kb, n0 = 32 * nb;
    const int n = n0 + (lane & 31); const bool ok = n < N;
#pragma unroll 8
    for (int i = 0; i < 32; ++i) { const int kk = 2 * i + (lane >> 5); scr[kk * 33 + (lane & 31)] = ok ? W[(size_t)(k0 + kk) * N + n] : 0.f; }
    LDS_WAIT();
    const int c = lane & 7;
    int orow0 = n0;
    if (mode == 1) orow0 = (n0 < 1024) ? ((n0 >> 7) * 256 + (n0 & 127)) : ((((n0 - 1024) >> 7) * 256) + 128 + ((n0 - 1024) & 127));
#pragma unroll
    for (int j = 0; j < 4; ++j) { const int nn = (lane >> 3) + 8 * j; const LAS float* s = scr + (8 * c) * 33 + nn;
        u32x4 o; o.x = pk2(s[0 * 33], s[1 * 33]); o.y = pk2(s[2 * 33], s[3 * 33]); o.z = pk2(s[4 * 33], s[5 * 33]); o.w = pk2(s[6 * 33], s[7 * 33]);
        *(u32x4*)(WT + (size_t)(orow0 + nn) * K + k0 + 8 * c) = o; }
    LDS_WAIT();
}

DI void phase_convert(const Ctx& C) {
    LAS float* scr = (LAS float*)(C.lds + C.wave * 16384);
    constexpr int I_EVEN = 16 * (EVEN_PAD / 32), I_ODD = 16 * (ODD_IN / 32), I_SQ = 16 * 32, I_KV = 16 * 64, I_GU = 16 * 64, I_DN = 16 * 32;
    constexpr int NITEMS = I_EVEN + I_ODD + 2 * I_SQ + 2 * I_SQ + 2 * I_KV + 2 * I_SQ + 64 * I_GU + 64 * I_DN;
    for (int it = C.gw; it < NITEMS; it += C.NGW) {
        int r = it;
        if (r < I_EVEN) { transpose_item(INP(float, 3), 1024, EVEN_IN, EVEN_PAD / 32, WSP(bf16, WS_WEVEN), 0, scr, r, C.lane); continue; } r -= I_EVEN;
        if (r < I_ODD) { transpose_item(INP(float, 12), 1024, ODD_IN, ODD_IN / 32, WSP(bf16, WS_WODD), 0, scr, r, C.lane); continue; } r -= I_ODD;
        if (r < I_SQ) { transpose_item(INP(float, 11), 1024, 1024, 32, WSP(bf16, WS_WOUTE), 0, scr, r, C.lane); continue; } r -= I_SQ;
        if (r < I_SQ) { transpose_item(INP(float, 17), 1024, 1024, 32, WSP(bf16, WS_WOUTO), 0, scr, r, C.lane); continue; } r -= I_SQ;
        if (r < 2 * I_SQ) { const int l = r / I_SQ; transpose_item(INP(float, 18) + (size_t)l * 1024 * 1024, 1024, 1024, 32, WSP(bf16, WS_WXQ) + (size_t)l * 1024 * 1024, 0, scr, r % I_SQ, C.lane); continue; } r -= 2 * I_SQ;
        if (r < 2 * I_KV) { const int l = r / I_KV; transpose_item(INP(float, 19) + (size_t)l * 1024 * 2048, 1024, 2048, 64, WSP(bf16, WS_WXKV) + (size_t)l * 2048 * 1024, 0, scr, r % I_KV, C.lane); continue; } r -= 2 * I_KV;
        if (r < 2 * I_SQ) { const int l = r / I_SQ; transpose_item(INP(float, 20) + (size_t)l * 1024 * 1024, 1024, 1024, 32, WSP(bf16, WS_WXO) + (size_t)l * 1024 * 1024, 0, scr, r % I_SQ, C.lane); continue; } r -= 2 * I_SQ;
        if (r < 64 * I_GU) { const int le = r / I_GU; transpose_item(INP(float, 25) + (size_t)le * 1024 * 2048, 1024, 2048, 64, WSP(bf16, WS_WGU) + (size_t)le * 2048 * 1024, 1, scr, r % I_GU, C.lane); continue; } r -= 64 * I_GU;
        { const int le = r / I_DN; transpose_item(INP(float, 27) + (size_t)le * 1024 * 1024, 1024, 1024, 32, WSP(bf16, WS_WDN) + (size_t)le * 1024 * 1024, 0, scr, r % I_DN, C.lane); }
    }
    const size_t gt = (size_t)C.bid * NTHREADS + C.tid, ngt = (size_t)C.G * NTHREADS;
    { const f32x4* x4 = INP(f32x4, 0); u32x2* o = WSP(u32x2, WS_XB);
      for (size_t i = gt; i < (size_t)T * DM / 4; i += ngt) { const f32x4 v = x4[i]; u32x2 w; w.x = pk2(v[0], v[1]); w.y = pk2(v[2], v[3]); o[i] = w; } }
    { const f32x4* x4 = INP(f32x4, 1); u32x2* o = WSP(u32x2, WS_MEMB);
      for (size_t i = gt; i < (size_t)NB * 256 * DM / 4; i += ngt) { const f32x4 v = x4[i]; u32x2 w; w.x = pk2(v[0], v[1]); w.y = pk2(v[2], v[3]); o[i] = w; } }
    { const int* pos = INP(int, 2); float* rc = WSP(float, WS_ROPEC); float* rs = WSP(float, WS_ROPES);
      for (size_t i = gt; i < (size_t)T * 32; i += ngt) { const int t = (int)(i >> 5), d = (int)(i & 31);
          const double inv = exp2(-(double)d * (13.287712379549449 / 32.0));
          const double ang = (double)pos[t] * inv;
          rc[i] = (float)cos(ang); rs[i] = (float)sin(ang); } }
}

DI void phase_nsa_prep(const Ctx& C) {
    const bf16* PROJ = WSP(bf16, R_PROJ); const float* RC = WSP(float, WS_ROPEC); const float* RS = WSP(float, WS_ROPES);
    bf16* QN = WSP(bf16, R_QN); bf16* QR = WSP(bf16, R_QR);
    bf16* KV6[6] = {WSP(bf16, R_KCMP), WSP(bf16, R_VCMP), WSP(bf16, R_KSLC), WSP(bf16, R_VSLC), WSP(bf16, R_KWIN), WSP(bf16, R_VWIN)};
    float* GATES = WSP(float, R_GATES); bf16* UG = WSP(bf16, R_UG); bf16* VN = WSP(bf16, R_VN);
    const float* lng = INP(float, 7); const float* lnb = INP(float, 8);
    const int lane = C.lane;
    for (int t = C.gw; t < T; t += C.NGW) {
        const bf16* pr = PROJ + (size_t)t * EVEN_PAD;
        const int b = t / SEQ, s = t % SEQ;
        const float cs = RC[(size_t)t * 32 + (lane & 31)], sn = RS[(size_t)t * 32 + (lane & 31)];
#pragma unroll
        for (int h = 0; h < 8; ++h) {
            const bf16 raw = pr[h * 64 + lane]; const float v = bf2f(raw); const float pv = __shfl_xor(v, 32);
            const float r = (lane < 32) ? (v * cs - pv * sn) : (v * cs + pv * sn);
            QN[(size_t)t * 512 + h * 64 + lane] = raw; QR[(size_t)t * 512 + h * 64 + lane] = (bf16)f2bf(r);
        }
#pragma unroll
        for (int i = 0; i < 6; ++i)
#pragma unroll
            for (int g = 0; g < 2; ++g) {
                const bf16 raw = pr[512 + i * 128 + g * 64 + lane]; bf16 o = raw;
                if (i == 2 || i == 4) { const float v = bf2f(raw); const float pv = __shfl_xor(v, 32); const float r = (lane < 32) ? (v * cs - pv * sn) : (v * cs + pv * sn); o = (bf16)f2bf(r); }
                KV6[i][((size_t)(b * 2 + g) * SEQ + s) * 64 + lane] = o;
            }
        if (lane < 24) GATES[(size_t)t * 24 + lane] = sigmoidf(bf2f(pr[1280 + lane]));
#pragma unroll
        for (int j = 0; j < 8; ++j) { const int c = lane + 64 * j; UG[(size_t)t * 512 + c] = (bf16)f2bf(gelu_tanh(bf2f(pr[1304 + c]))); }
#pragma unroll
        for (int g = 0; g < 4; ++g) {
            const float a0 = gelu_tanh(bf2f(pr[1816 + g * 128 + lane])), a1 = gelu_tanh(bf2f(pr[1816 + g * 128 + 64 + lane]));
            const float mean = wave_sum(a0 + a1) * (1.0f / 128.0f); const float d0 = a0 - mean, d1 = a1 - mean;
            const float var = wave_sum(d0 * d0 + d1 * d1) * (1.0f / 128.0f); const float rstd = 1.0f / sqrtf(var + 1e-5f);
            VN[(size_t)t * 512 + g * 128 + lane] = (bf16)f2bf(d0 * rstd * lng[g * 128 + lane] + lnb[g * 128 + lane]);
            VN[(size_t)t * 512 + g * 128 + 64 + lane] = (bf16)f2bf(d1 * rstd * lng[g * 128 + 64 + lane] + lnb[g * 128 + 64 + lane]);
        }
    }
}

DI void phase_cmp_hidden(const Ctx& C) {
    const int lane = C.lane; float* H1 = WSP(float, R_H1);
    constexpr int NIT = 2 * 8 * 2 * 255 * 4;
    for (int it0 = C.gw; it0 < NIT; it0 += C.NGW) {
        const int it = __builtin_amdgcn_readfirstlane(it0);
        const int jq = it & 3; int r = it >> 2; const int c = r % 255; r /= 255; const int g = r & 1; r >>= 1; const int b = r & 7; const int kv = r >> 3;
        const bf16* src = (kv ? WSP(bf16, R_VCMP) : WSP(bf16, R_KCMP)) + ((size_t)(b * 2 + g) * SEQ + 16 * c) * 64;
        const float* pos = INP(float, 4) + kv * 2048; const float* w = INP(float, 5) + (size_t)kv * 2048 * 256 + jq * 64 + lane;
        float acc = 0.f;
        for (int k = 0; k < 2048; k += 8) {
            const bf16x8 a8 = *(const bf16x8*)(src + k); const f32x4 p0 = *(const f32x4*)(pos + k), p1 = *(const f32x4*)(pos + k + 4);
#pragma unroll
            for (int e = 0; e < 8; ++e) { const float a = bf2f((bf16)a8[e]) + (e < 4 ? p0[e] : p1[e - 4]); acc += a * w[(size_t)(k + e) * 256]; }
        }
        H1[((size_t)kv * 4096 + (b * 2 + g) * 256 + c) * 256 + jq * 64 + lane] = gelu_tanh(acc);
    }
}
DI void phase_cmp_out(const Ctx& C) {
    const int lane = C.lane; const float* H1 = WSP(float, R_H1);
    for (int it0 = C.gw; it0 < 2 * 4096; it0 += C.NGW) {
        const int it = __builtin_amdgcn_readfirstlane(it0);
        const int kv = it >> 12, row = it & 4095, c = row & 255;
        bf16* dst = (kv ? WSP(bf16, R_VC) : WSP(bf16, R_KC)) + (size_t)row * 64 + lane;
        if (c == 255) { *dst = 0; continue; }
        const float* h = H1 + ((size_t)kv * 4096 + row) * 256; const float* w2 = INP(float, 6) + (size_t)kv * 256 * 64 + lane;
        float acc = 0.f;
        for (int j = 0; j < 256; ++j) acc += h[j] * w2[j * 64];
        *dst = (bf16)f2bf(acc);
    }
}

template <int D, int NH>
DI void wave_attn_blocks(const LAS float* qs, const bf16* Kb, size_t kstride, const bf16* Vb, size_t vstride, u64 blkmask, int spos, int window,
                         float (&o)[NH][D / 64], float (&m)[NH], float (&l)[NH], int lane) {
    while (blkmask) {
        const int j = __builtin_ctzll(blkmask); blkmask &= blkmask - 1;
        const int key = 64 * j + lane; const bool valid = (key <= spos) && (spos - key < window);
        const bf16* kr = Kb + (size_t)key * kstride;
        float sc[NH];
#pragma unroll
        for (int h = 0; h < NH; ++h) sc[h] = 0.f;
#pragma unroll 2
        for (int d0 = 0; d0 < D; d0 += 8) {
            const bf16x8 kk = *(const bf16x8*)(kr + d0);
#pragma unroll
            for (int h = 0; h < NH; ++h) { const f32x4 q0 = *(const LAS f32x4*)(qs + h * D + d0), q1 = *(const LAS f32x4*)(qs + h * D + d0 + 4);
#pragma unroll
                for (int e = 0; e < 8; ++e) sc[h] += (e < 4 ? q0[e] : q1[e - 4]) * bf2f((bf16)kk[e]); }
        }
        float p[NH];
#pragma unroll
        for (int h = 0; h < NH; ++h) {
            const float sv = valid ? sc[h] : -1e30f; const float bm = wave_max(sv); const float mn = fmaxf(m[h], bm);
            const float corr = __expf(m[h] - mn); p[h] = valid ? __expf(sc[h] - mn) : 0.f;
            l[h] = l[h] * corr + wave_sum(p[h]); m[h] = mn;
#pragma unroll
            for (int r = 0; r < D / 64; ++r) o[h][r] *= corr;
        }
#pragma unroll 4
        for (int i = 0; i < 64; ++i) {
            const bf16* vr = Vb + (size_t)(64 * j + i) * vstride + lane;
            float vv[D / 64];
#pragma unroll
            for (int r = 0; r < D / 64; ++r) vv[r] = bf2f(vr[64 * r]);
#pragma unroll
            for (int h = 0; h < NH; ++h) { const float pi = rdlane(p[h], i);
#pragma unroll
                for (int r = 0; r < D / 64; ++r) o[h][r] += pi * vv[r]; }
        }
    }
}

DI void phase_cmp_attn(const Ctx& C) {
    const int lane = C.lane;
    LAS float* qs = (LAS float*)(C.lds + C.wave * 16384); LAS float* Pl = qs + 256;
    const bf16* QN = WSP(bf16, R_QN); const float* GATES = WSP(float, R_GATES); float* OCMP = WSP(float, R_OCMP); u64* SELM = WSP(u64, R_SELM);
    for (int it0 = C.gw; it0 < T * 2; it0 += C.NGW) {
        const int it = __builtin_amdgcn_readfirstlane(it0);
        const int g = it & 1, t = it >> 1, b = t / SEQ, s = t % SEQ;
#pragma unroll
        for (int hh = 0; hh < 4; ++hh) qs[hh * 64 + lane] = bf2f(QN[(size_t)t * 512 + (g * 4 + hh) * 64 + lane]) * 0.125f;
        LDS_WAIT();
        const int nvalid = s >= 31 ? (s - 31) / 16 + 1 : 0;
        const bf16* KCb = WSP(bf16, R_KC) + (size_t)(b * 2 + g) * 256 * 64; const bf16* VCb = WSP(bf16, R_VC) + (size_t)(b * 2 + g) * 256 * 64;
        float p[4][4];
#pragma unroll
        for (int k = 0; k < 4; ++k) {
            const int c = lane + 64 * k; const bf16* kr = KCb + (size_t)c * 64;
            float sc[4] = {0.f, 0.f, 0.f, 0.f};
#pragma unroll 2
            for (int d0 = 0; d0 < 64; d0 += 8) { const bf16x8 kk = *(const bf16x8*)(kr + d0);
#pragma unroll
                for (int hh = 0; hh < 4; ++hh) { const f32x4 q0 = *(const LAS f32x4*)(qs + hh * 64 + d0), q1 = *(const LAS f32x4*)(qs + hh * 64 + d0 + 4);
#pragma unroll
                    for (int e = 0; e < 8; ++e) sc[hh] += (e < 4 ? q0[e] : q1[e - 4]) * bf2f((bf16)kk[e]); } }
#pragma unroll
            for (int hh = 0; hh < 4; ++hh) p[hh][k] = (c < nvalid) ? sc[hh] : -1e30f;
        }
        float psum[4] = {0.f, 0.f, 0.f, 0.f};
#pragma unroll
        for (int hh = 0; hh < 4; ++hh) {
            const float mx = wave_max(fmaxf(fmaxf(p[hh][0], p[hh][1]), fmaxf(p[hh][2], p[hh][3])));
            float ls = 0.f;
#pragma unroll
            for (int k = 0; k < 4; ++k) { const int c = lane + 64 * k; p[hh][k] = (c < nvalid) ? __expf(p[hh][k] - mx) : 0.f; ls += p[hh][k]; }
            ls = wave_sum(ls); const float inv = ls > 0.f ? 1.0f / ls : 0.f;
#pragma unroll
            for (int k = 0; k < 4; ++k) { p[hh][k] *= inv; psum[k] += p[hh][k]; }
        }
#pragma unroll
        for (int k = 0; k < 4; ++k) Pl[lane + 64 * k] = psum[k];
        LDS_WAIT();
        float imp = Pl[4 * lane] + Pl[4 * lane + 1] + Pl[4 * lane + 2] + 0.5f * Pl[4 * lane + 3];
        if (lane > 0) imp += 0.5f * Pl[4 * lane - 1];
        const int cur = s >> 6;
        const bool forced = (lane == 0) || (lane == cur) || (lane == cur - 1);
        const float score = forced ? 1e4f : (lane <= cur ? imp : -1.0f);
        int rank = 0;
#pragma unroll 8
        for (int i = 0; i < 64; ++i) { const float si = rdlane(score, i); rank += (si > score || (si == score && i < lane)) ? 1 : 0; }
        const u64 mask = __ballot(rank < 16);
        if (lane == 0) SELM[(size_t)(b * 2 + g) * SEQ + s] = mask;
        float o[4] = {0.f, 0.f, 0.f, 0.f};
#pragma unroll
        for (int k = 0; k < 4; ++k) {
            const int lim = nvalid - 64 * k < 64 ? nvalid - 64 * k : 64;
#pragma unroll 4
            for (int i = 0; i < lim; ++i) { const float vv = bf2f(VCb[(size_t)(64 * k + i) * 64 + lane]);
#pragma unroll
                for (int hh = 0; hh < 4; ++hh) o[hh] += rdlane(p[hh][k], i) * vv; }
        }
#pragma unroll
        for (int hh = 0; hh < 4; ++hh) OCMP[(size_t)t * 512 + (g * 4 + hh) * 64 + lane] = GATES[(size_t)t * 24 + g * 12 + hh * 3 + 0] * o[hh];
    }
}

DI void phase_slc_win_sgu(const Ctx& C) {
    const int lane = C.lane;
    LAS float* qs = (LAS float*)(C.lds + C.wave * 16384);
    const bf16* QR = WSP(bf16, R_QR); const float* GATES = WSP(float, R_GATES); const float* OCMP = WSP(float, R_OCMP); const u64* SELM = WSP(u64, R_SELM);
    bf16* MIXIN = WSP(bf16, WS_MIXIN);
    for (int it0 = C.gw; it0 < T * 2; it0 += C.NGW) {
        const int it = __builtin_amdgcn_readfirstlane(it0);
        const int g = it & 1, t = it >> 1, b = t / SEQ, s = t % SEQ, cur = s >> 6;
#pragma unroll
        for (int hh = 0; hh < 4; ++hh) qs[hh * 64 + lane] = bf2f(QR[(size_t)t * 512 + (g * 4 + hh) * 64 + lane]) * 0.125f;
        LDS_WAIT();
        const size_t kvo = (size_t)(b * 2 + g) * SEQ * 64;
        const u64 upto = (cur == 63) ? ~0ull : ((2ull << cur) - 1ull);
        float res[4];
        {   float o[4][1] = {{0.f}, {0.f}, {0.f}, {0.f}}, m[4] = {-1e30f, -1e30f, -1e30f, -1e30f}, l[4] = {0.f, 0.f, 0.f, 0.f};
            const u64 msk = SELM[(size_t)(b * 2 + g) * SEQ + s] & upto;
            wave_attn_blocks<64, 4>(qs, WSP(bf16, R_KSLC) + kvo, 64, WSP(bf16, R_VSLC) + kvo, 64, msk, s, 1 << 30, o, m, l, lane);
#pragma unroll
            for (int hh = 0; hh < 4; ++hh) res[hh] = GATES[(size_t)t * 24 + g * 12 + hh * 3 + 1] * (l[hh] > 0.f ? o[hh][0] / l[hh] : 0.f);
        }
        {   float o[4][1] = {{0.f}, {0.f}, {0.f}, {0.f}}, m[4] = {-1e30f, -1e30f, -1e30f, -1e30f}, l[4] = {0.f, 0.f, 0.f, 0.f};
            const int lo = cur - 8 > 0 ? cur - 8 : 0; const u64 msk = upto & ~((1ull << lo) - 1ull);
            wave_attn_blocks<64, 4>(qs, WSP(bf16, R_KWIN) + kvo, 64, WSP(bf16, R_VWIN) + kvo, 64, msk, s, 512, o, m, l, lane);
#pragma unroll
            for (int hh = 0; hh < 4; ++hh) res[hh] += GATES[(size_t)t * 24 + g * 12 + hh * 3 + 2] * (l[hh] > 0.f ? o[hh][0] / l[hh] : 0.f);
        }
#pragma unroll
        for (int hh = 0; hh < 4; ++hh) { const size_t idx = (size_t)t * 512 + (g * 4 + hh) * 64 + lane; MIXIN[(size_t)t * 1024 + (g * 4 + hh) * 64 + lane] = (bf16)f2bf(OCMP[idx] + res[hh]); }
    }
    const bf16* VN = WSP(bf16, R_VN); const bf16* UG = WSP(bf16, R_UG); const float* sw = INP(float, 9); const float* sb = INP(float, 10);
    for (int it0 = C.gw; it0 < NB * 32 * 4 * 128; it0 += C.NGW) {
        const int it = __builtin_amdgcn_readfirstlane(it0);
        const int tt = it & 127, g = (it >> 7) & 3, n = (it >> 9) & 31, b = it >> 14;
        const size_t tok0 = (size_t)b * SEQ + n * 128;
        const float* wrow = sw + (size_t)(g * 128 + tt) * 128;
        float a0 = 0.f, a1 = 0.f;
        for (int s2 = 0; s2 <= tt; ++s2) { const float w = wrow[s2]; const bf16* vr = VN + (tok0 + s2) * 512 + g * 128 + lane; a0 += w * bf2f(vr[0]); a1 += w * bf2f(vr[64]); }
        const float bias = sb[g * 128 + tt]; const size_t tok = tok0 + tt;
        MIXIN[tok * 1024 + 512 + g * 128 + lane] = (bf16)f2bf(bf2f(UG[tok * 512 + g * 128 + lane]) * (a0 + bias));
        MIXIN[tok * 1024 + 512 + g * 128 + 64 + lane] = (bf16)f2bf(bf2f(UG[tok * 512 + g * 128 + 64 + lane]) * (a1 + bias));
    }
}

DI void ln_row_finish(f32x4 (&v)[4], const float* gam, const float* bet, float* xo, bf16* xb, int lane) {
    float s = 0.f;
#pragma unroll
    for (int j = 0; j < 4; ++j) s += (v[j][0] + v[j][1]) + (v[j][2] + v[j][3]);
    const float mean = wave_sum(s) * (1.0f / DM); float s2 = 0.f;
#pragma unroll
    for (int j = 0; j < 4; ++j) { v[j] = v[j] - mean; s2 += (v[j][0] * v[j][0] + v[j][1] * v[j][1]) + (v[j][2] * v[j][2] + v[j][3] * v[j][3]); }
    const float rstd = 1.0f / sqrtf(wave_sum(s2) * (1.0f / DM) + 1e-5f);
#pragma unroll
    for (int j = 0; j < 4; ++j) { const f32x4 gg = ((const f32x4*)gam)[lane + 64 * j], bb = ((const f32x4*)bet)[lane + 64 * j];
        const f32x4 r = v[j] * rstd * gg + bb; ((f32x4*)xo)[lane + 64 * j] = r;
        u32x2 w; w.x = pk2(r[0], r[1]); w.y = pk2(r[2], r[3]); ((u32x2*)xb)[lane + 64 * j] = w; }
}
DI void phase_ln(const Ctx& C, const float* xprev, const float* y, const float* gam, const float* bet, float* xnext, bf16* xb) {
    for (int t = C.gw; t < T; t += C.NGW) {
        f32x4 v[4];
#pragma unroll
        for (int j = 0; j < 4; ++j) v[j] = ((const f32x4*)(xprev + (size_t)t * DM))[C.lane + 64 * j] * ALPHA + ((const f32x4*)(y + (size_t)t * DM))[C.lane + 64 * j];
        ln_row_finish(v, gam, bet, xnext + (size_t)t * DM, xb + (size_t)t * DM, C.lane);
    }
}

DI void phase_xattn(const Ctx& C, int layer) {
    const int lane = C.lane;
    LAS float* qs = (LAS float*)(C.lds + C.wave * 16384);
    const bf16* XQ = WSP(bf16, WS_XQ); const bf16* XKV = WSP(bf16, WS_XKV) + (size_t)layer * 2048 * 2048; bf16* XO = WSP(bf16, WS_XO);
    for (int it0 = C.gw; it0 < T * 4; it0 += C.NGW) {
        const int it = __builtin_amdgcn_readfirstlane(it0);
        const int h = it & 3, t = it >> 2, b = t / SEQ;
#pragma unroll
        for (int r = 0; r < 4; ++r) qs[lane + 64 * r] = bf2f(XQ[(size_t)t * 1024 + h * 256 + lane + 64 * r]) * 0.0625f;
        LDS_WAIT();
        float o[1][4] = {{0.f, 0.f, 0.f, 0.f}}, m[1] = {-1e30f}, l[1] = {0.f};
        const bf16* Kb = XKV + (size_t)b * 256 * 2048 + h * 256;
        wave_attn_blocks<256, 1>(qs, Kb, 2048, Kb + 1024, 2048, 0xFull, 1 << 29, 1 << 30, o, m, l, lane);
        const float inv = 1.0f / l[0];
#pragma unroll
        for (int r = 0; r < 4; ++r) XO[(size_t)t * 1024 + h * 256 + lane + 64 * r] = (bf16)f2bf(o[0][r] * inv);
    }
}

DI void phase_router(const Ctx& C, int layer, const float* x) {
    const int lane = C.lane, e = lane & 31, half = lane >> 5;
    unsigned char* tab = C.ws + WS_MOETAB + (size_t)layer * 2 * MiB;
    int* TOKE = (int*)(tab + MT_TOKE); float* TOKG = (float*)(tab + MT_TOKG); int* HIST = (int*)(tab + MT_HIST);
    const float* rw = INP(float, 23) + (size_t)layer * 1024 * 32; const float* rb = INP(float, 24) + layer * 32;
    LAS int* hist = (LAS int*)(C.lds);
    for (int chunk = C.bid; chunk < 256; chunk += C.G) {
        if (C.tid < 32) hist[C.tid] = 0;
        __syncthreads();
        for (int i = 0; i < 16; ++i) {
            const int t = chunk * 128 + C.wave * 16 + i;
            const float* xr = x + (size_t)t * DM + half * 512;
            float acc = 0.f;
            for (int k = 0; k < 512; k += 4) { const f32x4 xv = *(const f32x4*)(xr + k); const float* wp = rw + (size_t)(half * 512 + k) * 32 + e;
                acc += xv[0] * wp[0] + xv[1] * wp[32] + xv[2] * wp[64] + xv[3] * wp[96]; }
            acc += __shfl_xor(acc, 32);
            float val = acc + rb[e];
            float tv[4]; int ti[4];
#pragma unroll
            for (int r = 0; r < 4; ++r) {
                float best = val; int bi = e;
#pragma unroll
                for (int off = 16; off >= 1; off >>= 1) { const float ov = __shfl_xor(best, off); const int oi = __shfl_xor(bi, off); if (ov > best || (ov == best && oi < bi)) { best = ov; bi = oi; } }
                tv[r] = best; ti[r] = bi; if (e == bi) val = -3.0e38f;
            }
            const float e1 = __expf(tv[1] - tv[0]), e2 = __expf(tv[2] - tv[0]), e3 = __expf(tv[3] - tv[0]); const float inv = 1.0f / (1.0f + e1 + e2 + e3);
            if (lane == 0) {
                TOKE[t * 4 + 0] = ti[0]; TOKE[t * 4 + 1] = ti[1]; TOKE[t * 4 + 2] = ti[2]; TOKE[t * 4 + 3] = ti[3];
                TOKG[t * 4 + 0] = inv; TOKG[t * 4 + 1] = e1 * inv; TOKG[t * 4 + 2] = e2 * inv; TOKG[t * 4 + 3] = e3 * inv;
                atomicAdd((int*)(hist + ti[0]), 1); atomicAdd((int*)(hist + ti[1]), 1); atomicAdd((int*)(hist + ti[2]), 1); atomicAdd((int*)(hist + ti[3]), 1);
            }
        }
        __syncthreads();
        if (C.tid < 32) HIST[chunk * 32 + C.tid] = hist[C.tid];
        __syncthreads();
    }
}
DI void phase_moe_scatter(const Ctx& C, int layer) {
    const int lane = C.lane, tid = C.tid;
    unsigned char* tab = C.ws + WS_MOETAB + (size_t)layer * 2 * MiB;
    const int* TOKE = (const int*)(tab + MT_TOKE); int* TOKSLOT = (int*)(tab + MT_TOKSLOT); const int* HIST = (const int*)(tab + MT_HIST); int* TILEE = (int*)(tab + MT_TILEE);
    const bf16* XB = WSP(bf16, WS_XB); bf16* XG = WSP(bf16, R_XG);
    LAS int* tot = (LAS int*)(C.lds);
    LAS int* ebase = tot + 32;
    LAS int* cntl = tot + 96;
    LAS int* slots = tot + 128;
    if (tid < 32) { int s = 0; for (int c = 0; c < 256; ++c) s += HIST[c * 32 + tid]; tot[tid] = s; }
    __syncthreads();
    if (tid == 0) { int acc = 0; for (int e = 0; e < 32; ++e) { ebase[e] = acc; acc += (tot[e] + 255) & ~255; } ebase[32] = acc; }
    __syncthreads();
    if (C.bid == 0) { const int nmt = ebase[32] >> 8; for (int mt = tid; mt < nmt; mt += NTHREADS) { int e = 0; while (e < 31 && (mt << 8) >= ebase[e + 1]) ++e; TILEE[mt] = e; } if (tid == 0) TILEE[1023] = nmt; }
    for (int e = C.bid; e < 32; e += C.G) { const int r0 = ebase[e] + tot[e], r1 = ebase[e + 1];
        for (int r = r0 + C.wave; r < r1; r += NWAVES) { u32x4* p = (u32x4*)(XG + (size_t)r * 1024); p[lane] = (u32x4){0u, 0u, 0u, 0u}; p[lane + 64] = (u32x4){0u, 0u, 0u, 0u}; } }
    for (int chunk = C.bid; chunk < 256; chunk += C.G) {
        __syncthreads();
        if (tid < 32) { int s = ebase[tid]; for (int c = 0; c < chunk; ++c) s += HIST[c * 32 + tid]; cntl[tid] = s; }
        __syncthreads();
        if (C.wave == 0) {
            for (int bt = 0; bt < 8; ++bt) {
                const int idx = bt * 64 + lane; const int my_e = TOKE[(size_t)chunk * 512 + idx];
                int slot = 0;
                for (int e = 0; e < 32; ++e) { const u64 mm = __ballot(my_e == e); if (mm) { const int base = cntl[e]; if (my_e == e) slot = base + __popcll(mm & ((1ull << lane) - 1ull)); LDS_WAIT(); if (lane == 0) cntl[e] = base + __popcll(mm); LDS_WAIT(); } }
                slots[idx] = slot; TOKSLOT[(size_t)chunk * 512 + idx] = slot;
            }
        }
        __syncthreads();
        for (int i = C.wave; i < 512; i += NWAVES) { const int t = chunk * 128 + (i >> 2); const int slot = slots[i];
            const u32x4* src = (const u32x4*)(XB + (size_t)t * 1024); u32x4* dst = (u32x4*)(XG + (size_t)slot * 1024);
            dst[lane] = src[lane]; dst[lane + 64] = src[lane + 64]; }
    }
}
DI void phase_moe_combine_ln(const Ctx& C, int layer, const float* xprev, const float* gam, const float* bet, float* xnext, bf16* xb) {
    unsigned char* tab = C.ws + WS_MOETAB + (size_t)layer * 2 * MiB;
    const float* TOKG = (const float*)(tab + MT_TOKG); const int* TOKSLOT = (const int*)(tab + MT_TOKSLOT); const bf16* YEXP = WSP(bf16, R_YEXP);
    for (int t = C.gw; t < T; t += C.NGW) {
        f32x4 v[4];
#pragma unroll
        for (int j = 0; j < 4; ++j) v[j] = ((const f32x4*)(xprev + (size_t)t * DM))[C.lane + 64 * j] * ALPHA;
#pragma unroll
        for (int r = 0; r < 4; ++r) { const float gt = TOKG[t * 4 + r]; const int slot = TOKSLOT[t * 4 + r]; const u32x2* yr = (const u32x2*)(YEXP + (size_t)slot * 1024);
#pragma unroll
            for (int j = 0; j < 4; ++j) { const u32x2 w = yr[C.lane + 64 * j];
                v[j][0] += gt * __uint_as_float(w.x << 16); v[j][1] += gt * __uint_as_float(w.x & 0xffff0000u); v[j][2] += gt * __uint_as_float(w.y << 16); v[j][3] += gt * __uint_as_float(w.y & 0xffff0000u); } }
        ln_row_finish(v, gam, bet, xnext + (size_t)t * DM, xb + (size_t)t * DM, C.lane);
    }
}

DI void phase_hgrn_prep(const Ctx& C) {
    const int lane = C.lane; const bf16* PROJ = WSP(bf16, R_PROJ); float* F = WSP(float, R_FBUF); bf16* MIXIN = WSP(bf16, WS_MIXIN);
    const float* lbl = INP(float, 13); const float* cw = INP(float, 15); const float* cb = INP(float, 16);
    for (int t = C.gw; t < T; t += C.NGW) {
        const int s = t % SEQ; const bf16* pr = PROJ + (size_t)t * ODD_IN;
#pragma unroll
        for (int j = 0; j < 8; ++j) {
            const int c = lane + 64 * j;
            const float l0 = lbl[c], l1 = lbl[512 + c]; const float lb = 1.0f / (1.0f + __expf(l0 - l1));
            F[(size_t)t * 512 + c] = lb + (1.0f - lb) * sigmoidf(bf2f(pr[512 + c]));
            const float z0 = bf2f(pr[3072 + c]) * bf2f(pr[2048 + c]);
            const float z1 = s >= 1 ? bf2f(pr[3072 + c - ODD_IN]) * bf2f(pr[2048 + c - ODD_IN]) : 0.f;
            const float z2 = s >= 2 ? bf2f(pr[3072 + c - 2 * ODD_IN]) * bf2f(pr[2048 + c - 2 * ODD_IN]) : 0.f;
            const float y = cw[c] * z2 + cw[512 + c] * z1 + cw[1024 + c] * z0 + cb[c];
            MIXIN[(size_t)t * 1024 + 512 + c] = (bf16)f2bf(bf2f(pr[2560 + c]) * y);
        }
    }
}
DI void phase_hgrn_scan(const Ctx& C) {
    const int lane = C.lane, kq = lane >> 4, vv = lane & 15, v = C.wave * 16 + vv;
    const bf16* PROJ = WSP(bf16, R_PROJ); const float* F = WSP(float, R_FBUF); float* ORAW = WSP(float, R_ORAW);
    for (int bh = C.bid; bh < 32; bh += C.G) {
        const int b = bh >> 2, h = bh & 3;
        float S[32];
#pragma unroll
        for (int j = 0; j < 32; ++j) S[j] = 0.f;
        for (int s = 0; s < SEQ; ++s) {
            const size_t t = (size_t)b * SEQ + s;
            const float* fp = F + t * 512 + h * 128 + kq * 32; const bf16* qp = PROJ + t * ODD_IN + h * 128 + kq * 32;
            const float iv = bf2f(PROJ[t * ODD_IN + 1024 + h * 128 + v]);
            float o = 0.f;
#pragma unroll
            for (int j8 = 0; j8 < 4; ++j8) {
                const f32x4 f0 = *(const f32x4*)(fp + 8 * j8), f1 = *(const f32x4*)(fp + 8 * j8 + 4); const bf16x8 q8 = *(const bf16x8*)(qp + 8 * j8);
#pragma unroll
                for (int e = 0; e < 8; ++e) { const float f = e < 4 ? f0[e] : f1[e - 4]; const int j = 8 * j8 + e; S[j] = f * S[j] + (1.0f - f) * iv; o += bf2f((bf16)q8[e]) * S[j]; }
            }
            o += __shfl_xor(o, 16); o += __shfl_xor(o, 32);
            if (kq == 0) ORAW[t * 512 + h * 128 + v] = o;
        }
    }
}
DI void phase_hgrn_norm(const Ctx& C) {
    const int lane = C.lane; const bf16* PROJ = WSP(bf16, R_PROJ); const float* ORAW = WSP(float, R_ORAW); bf16* MIXIN = WSP(bf16, WS_MIXIN); const float* ng = INP(float, 14);
    for (int it0 = C.gw; it0 < T * 4; it0 += C.NGW) {
        const int it = __builtin_amdgcn_readfirstlane(it0); const int h = it & 3; const size_t t = it >> 2;
        const float o0 = ORAW[t * 512 + h * 128 + lane], o1 = ORAW[t * 512 + h * 128 + 64 + lane];
        const float ms = wave_sum(o0 * o0 + o1 * o1) * (1.0f / 128.0f); const float r = 1.0f / sqrtf(ms + 1e-6f);
        const float g0 = bf2f(PROJ[t * ODD_IN + 1536 + h * 128 + lane]), g1 = bf2f(PROJ[t * ODD_IN + 1536 + h * 128 + 64 + lane]);
        MIXIN[t * 1024 + h * 128 + lane] = (bf16)f2bf(o0 * r * ng[h * 128 + lane] * (g0 * sigmoidf(g0)));
        MIXIN[t * 1024 + h * 128 + 64 + lane] = (bf16)f2bf(o1 * r * ng[h * 128 + 64 + lane] * (g1 * sigmoidf(g1)));
    }
}

DI void gemm_bf16out(const Ctx& C, const bf16* A, const bf16* Bt, int M, int N, bf16* O, int ldc) {
    pg8::DenseOrder S; S.init(A, 1024, Bt, 1024, M, N, C.G, C.bid);
    pg8::EpiBf16 E{O, ldc, nullptr, 0};
    pg8::gemm_phase<pg8::EpiBf16, pg8::DenseOrder>(C.lds, 1024, 1024, 1024, S, E);
}
DI void gemm_f32out(const Ctx& C, const bf16* A, const bf16* Bt, int M, int N, float* O, int ldc) {
    pg8::DenseOrder S; S.init(A, 1024, Bt, 1024, M, N, C.G, C.bid);
    pg8::EpiF32 E{O, ldc};
    pg8::gemm_phase<pg8::EpiF32, pg8::DenseOrder>(C.lds, 1024, 1024, 1024, S, E);
}
DI void gemm_moe_gu(const Ctx& C, int layer) {
    unsigned char* tab = C.ws + WS_MOETAB + (size_t)layer * 2 * MiB; const int* TILEE = (const int*)(tab + MT_TILEE);
    const int nmt = (int)__hip_atomic_load((const unsigned*)TILEE + 1023, __ATOMIC_RELAXED, __HIP_MEMORY_SCOPE_AGENT);
    pg8::MoeOrder S; S.init(WSP(bf16, R_XG), WSP(bf16, WS_WGU) + (size_t)layer * 32 * 2048 * 1024, 2048, TILEE, nmt, C.G, C.bid);
    pg8::EpiSwiglu E{WSP(bf16, R_ACT), INP(float, 26) + (size_t)layer * 32 * 2048};
    pg8::gemm_phase<pg8::EpiSwiglu, pg8::MoeOrder>(C.lds, 1024, 1024, 1024, S, E);
}
DI void gemm_moe_dn(const Ctx& C, int layer) {
    unsigned char* tab = C.ws + WS_MOETAB + (size_t)layer * 2 * MiB; const int* TILEE = (const int*)(tab + MT_TILEE);
    const int nmt = (int)__hip_atomic_load((const unsigned*)TILEE + 1023, __ATOMIC_RELAXED, __HIP_MEMORY_SCOPE_AGENT);
    pg8::MoeOrder S; S.init(WSP(bf16, R_ACT), WSP(bf16, WS_WDN) + (size_t)layer * 32 * 1024 * 1024, 1024, TILEE, nmt, C.G, C.bid);
    pg8::EpiBf16 E{WSP(bf16, R_YEXP), 1024, INP(float, 28) + (size_t)layer * 32 * 1024, 1024};
    pg8::gemm_phase<pg8::EpiBf16, pg8::MoeOrder>(C.lds, 1024, 1024, 1024, S, E);
}

constexpr int N_PHASES = 33;
__global__ void __launch_bounds__(NTHREADS, 2) mega(Args args) {
    extern __shared__ __attribute__((aligned(16))) unsigned char lds_raw[];
    Ctx C;
    C.lds = (LAS unsigned char*)lds_raw; C.ws = args.ws; C.a = &args;
    C.tid = threadIdx.x; C.lane = C.tid & 63; C.wave = __builtin_amdgcn_readfirstlane(C.tid >> 6); C.bid = blockIdx.x; C.G = gridDim.x;
    C.gw = C.bid * NWAVES + C.wave; C.NGW = C.G * NWAVES;
    volatile LAS unsigned* MISC = (volatile LAS unsigned*)(C.lds + LDSCTL_OFF);
    for (int u = C.tid; u < (LDS_BYTES - LDSCTL_OFF) / 4; u += NTHREADS) MISC[u] = 0u;
    __syncthreads();
    const int lo = args.ph_lo, hi = args.ph_hi;
    XcdBarrier bar; bar.bar = (unsigned*)(C.ws + WS_CTL) + CW_BAR; bar.x = 0; bar.st = nullptr;
    if (hi - lo > 1) bar = xcd_barrier_post((unsigned*)(C.ws + WS_CTL) + CW_BAR, MISC + 8);
#ifndef PHMASK
#define PHMASK 0x1ffffffffull
#endif
#define IN(k) ((((PHMASK) >> (k)) & 1ull) && lo <= (k) && (k) < hi)
#define SEAM(k) do { if (IN(k) && IN((k) + 1)) xcd_barrier(bar); } while (0)
    const float* lng = INP(float, 21); const float* lnb = INP(float, 22);
    float* XA = WSP(float, WS_XA); float* XBF = WSP(float, WS_XBF); bf16* XB = WSP(bf16, WS_XB);

    if (IN(0)) { phase_convert(C); } SEAM(0);
    if (IN(1)) {
        gemm_bf16out(C, XB, WSP(bf16, WS_WEVEN), T, EVEN_PAD, WSP(bf16, R_PROJ), EVEN_PAD);
        gemm_bf16out(C, WSP(bf16, WS_MEMB), WSP(bf16, WS_WXKV), 2048, 2048, WSP(bf16, WS_XKV), 2048);
        gemm_bf16out(C, WSP(bf16, WS_MEMB), WSP(bf16, WS_WXKV) + (size_t)2048 * 1024, 2048, 2048, WSP(bf16, WS_XKV) + (size_t)2048 * 2048, 2048);
    } SEAM(1);
    if (IN(2)) { phase_nsa_prep(C); } SEAM(2);
    if (IN(3)) { phase_cmp_hidden(C); } SEAM(3);
    if (IN(4)) { phase_cmp_out(C); } SEAM(4);
    if (IN(5)) { phase_cmp_attn(C); } SEAM(5);
    if (IN(6)) { phase_slc_win_sgu(C); } SEAM(6);
    if (IN(7)) { gemm_f32out(C, WSP(bf16, WS_MIXIN), WSP(bf16, WS_WOUTE), T, 1024, WSP(float, WS_YBUF), 1024); } SEAM(7);
    if (IN(8)) { phase_ln(C, INP(float, 0), WSP(float, WS_YBUF), lng + 0 * 1024, lnb + 0 * 1024, XA, XB); } SEAM(8);
    if (IN(9)) { gemm_bf16out(C, XB, WSP(bf16, WS_WXQ), T, 1024, WSP(bf16, WS_XQ), 1024); } SEAM(9);
    if (IN(10)) { phase_xattn(C, 0); } SEAM(10);
    if (IN(11)) { gemm_f32out(C, WSP(bf16, WS_XO), WSP(bf16, WS_WXO), T, 1024, WSP(float, WS_YBUF), 1024); } SEAM(11);
    if (IN(12)) { phase_ln(C, XA, WSP(float, WS_YBUF), lng + 1 * 1024, lnb + 1 * 1024, XBF, XB); } SEAM(12);
    if (IN(13)) { phase_router(C, 0, XBF); } SEAM(13);
    if (IN(14)) { phase_moe_scatter(C, 0); } SEAM(14);
    if (IN(15)) { gemm_moe_gu(C, 0); } SEAM(15);
    if (IN(16)) { gemm_moe_dn(C, 0); } SEAM(16);
    if (IN(17)) { phase_moe_combine_ln(C, 0, XBF, lng + 2 * 1024, lnb + 2 * 1024, XA, XB); } SEAM(17);
    if (IN(18)) { gemm_bf16out(C, XB, WSP(bf16, WS_WODD), T, ODD_IN, WSP(bf16, R_PROJ), ODD_IN); } SEAM(18);
    if (IN(19)) { phase_hgrn_prep(C); } SEAM(19);
    if (IN(20)) { phase_hgrn_scan(C); } SEAM(20);
    if (IN(21)) { phase_hgrn_norm(C); } SEAM(21);
    if (IN(22)) { gemm_f32out(C, WSP(bf16, WS_MIXIN), WSP(bf16, WS_WOUTO), T, 1024, WSP(float, WS_YBUF), 1024); } SEAM(22);
    if (IN(23)) { phase_ln(C, XA, WSP(float, WS_YBUF), lng + 3 * 1024, lnb + 3 * 1024, XBF, XB); } SEAM(23);
    if (IN(24)) { gemm_bf16out(C, XB, WSP(bf16, WS_WXQ) + (size_t)1024 * 1024, T, 1024, WSP(bf16, WS_XQ), 1024); } SEAM(24);
    if (IN(25)) { phase_xattn(C, 1); } SEAM(25);
    if (IN(26)) { gemm_f32out(C, WSP(bf16, WS_XO), WSP(bf16, WS_WXO) + (size_t)1024 * 1024, T, 1024, WSP(float, WS_YBUF), 1024); } SEAM(26);
    if (IN(27)) { phase_ln(C, XBF, WSP(float, WS_YBUF), lng + 4 * 1024, lnb + 4 * 1024, XA, XB); } SEAM(27);
    if (IN(28)) { phase_router(C, 1, XA); } SEAM(28);
    if (IN(29)) { phase_moe_scatter(C, 1); } SEAM(29);
    if (IN(30)) { gemm_moe_gu(C, 1); } SEAM(30);
    if (IN(31)) { gemm_moe_dn(C, 1); } SEAM(31);
    if (IN(32)) { phase_moe_combine_ln(C, 1, XA, lng + 5 * 1024, lnb + 5 * 1024, args.out, XB); }
}

extern "C" void kernel_launch(void* const* d_in, const int* in_sizes, int n_in, void* d_out, int out_size, void* d_ws, size_t ws_size, hipStream_t stream) {
    static int grid = 0;
    if (grid == 0) {
        if (n_in != 29 || ws_size < WS_END) { fprintf(stderr, "kernel_launch: unexpected n_in %d / ws_size %zu (need %zu)\n", n_in, ws_size, (size_t)WS_END); grid = -1; return; }
        int dev = 0, cus = 0, per_cu = 0;
        hipGetDevice(&dev); hipDeviceGetAttribute(&cus, hipDeviceAttributeMultiprocessorCount, dev);
        if (hipFuncSetAttribute((const void*)mega, hipFuncAttributeMaxDynamicSharedMemorySize, LDS_BYTES) != hipSuccess) { fprintf(stderr, "kernel_launch: hipFuncSetAttribute failed\n"); grid = -1; return; }
        hipOccupancyMaxActiveBlocksPerMultiprocessor(&per_cu, (const void*)mega, NTHREADS, LDS_BYTES);
        if (per_cu < 1) fprintf(stderr, "kernel_launch: occupancy query says %d\n", per_cu);
        grid = cus > 0 ? cus : 256;
    }
    if (grid < 0) return;
    hipMemsetAsync((char*)d_ws + WS_CTL, 0, CTL_BYTES, stream);
    Args a{};
    for (int i = 0; i < 29; ++i) a.in[i] = d_in[i];
    a.out = (float*)d_out; a.ws = (unsigned char*)d_ws;
#if ONE_LAUNCH
    a.ph_lo = 0; a.ph_hi = N_PHASES;
    hipLaunchKernelGGL(mega, dim3(grid), dim3(NTHREADS), LDS_BYTES, stream, a);
#else
    for (int p = 0; p < N_PHASES; ++p) { a.ph_lo = p; a.ph_hi = p + 1; hipLaunchKernelGGL(mega, dim3(grid), dim3(NTHREADS), LDS_BYTES, stream, a); }
#endif
}
```

```cpp
#include <hip/hip_runtime.h>
#include <cstdio>
#include <cstdint>

#ifndef ONE_LAUNCH
#define ONE_LAUNCH 1
#endif

#define LAS __attribute__((address_space(3)))
#define DI __device__ __forceinline__
typedef unsigned short bf16;
typedef short bf16x8 __attribute__((ext_vector_type(8)));
typedef float f32x4 __attribute__((ext_vector_type(4)));
typedef float f32x2 __attribute__((ext_vector_type(2)));
typedef unsigned u32x4 __attribute__((ext_vector_type(4)));
typedef unsigned u32x2 __attribute__((ext_vector_type(2)));
typedef unsigned long long u64;

constexpr int NB = 8, SEQ = 4096, T = NB * SEQ, DM = 1024;
constexpr int EVEN_IN = 2328, EVEN_PAD = 2560, ODD_IN = 3584;
constexpr int NEXP = 32, TOPK = 4;
constexpr int XG_ROWS = T * TOPK + NEXP * 256;
constexpr float ALPHA = 1.41421356237f;
constexpr int NWAVES = 8, NTHREADS = 512;

constexpr size_t MiB = 1u << 20;
constexpr size_t WS_CTL = 0, CTL_BYTES = 1 * MiB;
constexpr size_t WS_WEVEN = 1 * MiB, WS_WODD = 6 * MiB, WS_WOUTE = 13 * MiB, WS_WOUTO = 15 * MiB, WS_WXQ = 17 * MiB, WS_WXKV = 21 * MiB, WS_WXO = 29 * MiB;
constexpr size_t WS_WGU = 33 * MiB, WS_WDN = 289 * MiB;
constexpr size_t WS_XB = 417 * MiB, WS_MEMB = 481 * MiB, WS_ROPEC = 485 * MiB, WS_ROPES = 489 * MiB;
constexpr size_t WS_MIXIN = 493 * MiB, WS_YBUF = 557 * MiB, WS_XA = 685 * MiB, WS_XBF = 813 * MiB;
constexpr size_t WS_XKV = 941 * MiB, WS_XQ = 957 * MiB, WS_XO = 1021 * MiB, WS_MOETAB = 1085 * MiB, WS_R1 = 1089 * MiB, WS_SMALL = 1905 * MiB, WS_END = 1909 * MiB;
constexpr size_t WS_W1T = WS_SMALL, WS_W2T = WS_SMALL + 2 * MiB, WS_SGW = WS_SMALL + 2 * MiB + 256 * 1024, WS_BP = WS_SMALL + 2 * MiB + 384 * 1024;
constexpr size_t R_PROJ = WS_R1, R_QN = WS_R1 + 224 * MiB, R_QR = WS_R1 + 256 * MiB, R_KCMP = WS_R1 + 288 * MiB, R_VCMP = WS_R1 + 297 * MiB;
constexpr size_t R_KSLC = WS_R1 + 306 * MiB, R_VSLC = WS_R1 + 314 * MiB, R_KWIN = WS_R1 + 322 * MiB, R_VWIN = WS_R1 + 330 * MiB;
constexpr size_t R_GATES = WS_R1 + 338 * MiB, R_UG = WS_R1 + 341 * MiB, R_VN = WS_R1 + 373 * MiB, R_H1 = WS_R1 + 405 * MiB;
constexpr size_t R_KC = WS_R1 + 413 * MiB, R_VC = WS_R1 + 414 * MiB, R_SELM = WS_R1 + 415 * MiB, R_OCMP = WS_R1 + 416 * MiB;
constexpr size_t R_FBUF = WS_R1 + 480 * MiB, R_ORAW = WS_R1 + 544 * MiB;
constexpr size_t R_XG = WS_R1, R_ACT = WS_R1 + 272 * MiB, R_YEXP = WS_R1 + 544 * MiB;
constexpr size_t MT_TOKE = 0, MT_TOKG = 512 * 1024, MT_TOKSLOT = 1024 * 1024, MT_HIST = 1536 * 1024, MT_TILEE = 1536 * 1024 + 64 * 1024;
constexpr int CW_BAR = 4096;

constexpr int STAGE_BYTES_LDS = 131072, LDSCTL_OFF = 131072, LDS_BYTES = 147456;

DI float bf2f(bf16 v) { return __uint_as_float(((unsigned)v) << 16); }
DI unsigned f2bf(float f) { unsigned u = __float_as_uint(f); return (u + 0x7fffu + ((u >> 16) & 1u)) >> 16; }
DI unsigned pk2(float lo, float hi) { return f2bf(lo) | (f2bf(hi) << 16); }
DI float wave_sum(float v) {
#pragma unroll
    for (int o = 1; o < 64; o <<= 1) v += __shfl_xor(v, o);
    return v;
}
DI float wave_max(float v) {
#pragma unroll
    for (int o = 1; o < 64; o <<= 1) v = fmaxf(v, __shfl_xor(v, o));
    return v;
}
DI float rdlane(float x, int i) { return __builtin_bit_cast(float, __builtin_amdgcn_readlane(__builtin_bit_cast(int, x), i)); }
DI float gelu_tanh(float x) { const float u = 0.7978845608028654f * (x + 0.044715f * x * x * x); return 0.5f * x * (1.0f + tanhf(u)); }
DI float sigmoidf(float x) { return 1.0f / (1.0f + __expf(-x)); }
#define LDS_WAIT() asm volatile("s_waitcnt lgkmcnt(0)" ::: "memory")

#define XB_TMO      128
#define XB_XCNT(j)  (256  + 64 * (j))
#define XB_XSUB(j)  (1280 + 64 * (j))
#define XB_XGEN(j)  (2304 + 64 * (j))
#define XB_TOP      3328
#define XB_TOPGEN   3392
#define XCD_BAR_WORDS 3456
#define XB_SPIN_CAP (1u << 18)
__device__ __forceinline__ unsigned xb_ld(unsigned* p)              { return __hip_atomic_load(p, __ATOMIC_RELAXED, __HIP_MEMORY_SCOPE_AGENT); }
__device__ __forceinline__ unsigned xb_add(unsigned* p, unsigned v) { return __hip_atomic_fetch_add(p, v, __ATOMIC_RELAXED, __HIP_MEMORY_SCOPE_AGENT); }
__device__ __forceinline__ unsigned xb_xcc_id() { return (unsigned)__builtin_amdgcn_s_getreg((3 << 11) | 20) & 0xFu; }
#define XB_SPIN(cond, bar) do { unsigned _sp = 0; while (cond) { __builtin_amdgcn_s_sleep(1); \
    if ((++_sp & 255u) == 0u) { if (xb_ld(&(bar)[XB_TMO])) break; if (_sp > XB_SPIN_CAP) { atomicAdd(&(bar)[XB_TMO], 1u); break; } } } } while (0)
struct XcdBarrier { unsigned* bar; unsigned x; volatile LAS unsigned* st; };
__device__ __forceinline__ XcdBarrier xcd_barrier_post(unsigned* bar, volatile LAS unsigned* st) {
    XcdBarrier b; b.bar = bar; b.x = xb_xcc_id(); b.st = st;
    if (threadIdx.x == 0) (void)xb_add(&bar[XB_XCNT(b.x)], 1u);
    return b;
}
__device__ __forceinline__ void xcd_barrier_complete(unsigned* bar, unsigned x, unsigned& nloc, unsigned& nx) {
    const unsigned G = gridDim.x * gridDim.y * gridDim.z;
    unsigned sum, cnt, mine, sp = 0u;
    for (;;) {
        sum = 0u; cnt = 0u; mine = 0u;
#pragma unroll
        for (unsigned j = 0; j < 16; ++j) { const unsigned c = xb_ld(&bar[XB_XCNT(j)]); sum += c; cnt += (c > 0u) ? 1u : 0u; mine = (j == x) ? c : mine; }
        if (sum == G) break;
        __builtin_amdgcn_s_sleep(1);
        if ((++sp & 255u) == 0u) { if (xb_ld(&bar[XB_TMO])) break; if (sp > XB_SPIN_CAP) { atomicAdd(&bar[XB_TMO], 1u); break; } }
    }
    nloc = mine > 0u ? mine : 1u; nx = cnt > 0u ? cnt : 1u;
}
__device__ __forceinline__ void xcd_barrier(const XcdBarrier& b) {
    asm volatile("s_waitcnt vmcnt(0)" ::: "memory");
    __syncthreads();
    if (threadIdx.x == 0) {
        unsigned* bar = b.bar;
        __builtin_amdgcn_s_waitcnt(0);
        unsigned nloc = b.st[0], nx = b.st[1];
        if (nloc == 0u) { xcd_barrier_complete(bar, b.x, nloc, nx); b.st[0] = nloc; b.st[1] = nx; }
        const unsigned old = xb_add(&bar[XB_XSUB(b.x)], 1u);
        const unsigned gen = old / nloc;
        if (old + 1u == (gen + 1u) * nloc) {
            __builtin_amdgcn_fence(__ATOMIC_RELEASE, "agent");
            asm volatile("s_waitcnt vmcnt(0)" ::: "memory");
            const unsigned og = xb_add(&bar[XB_TOP], 1u);
            const unsigned tg = og / nx;
            if (og + 1u == (tg + 1u) * nx) xb_add(&bar[XB_TOPGEN], 1u);
            else XB_SPIN(xb_ld(&bar[XB_TOPGEN]) == tg, bar);
            __builtin_amdgcn_fence(__ATOMIC_ACQUIRE, "agent");
            xb_add(&bar[XB_XGEN(b.x)], 1u);
            asm volatile("s_waitcnt vmcnt(0)" ::: "memory");
        } else {
            XB_SPIN(xb_ld(&bar[XB_XGEN(b.x)]) == gen, bar);
            __builtin_amdgcn_fence(__ATOMIC_ACQUIRE, "agent");
            asm volatile("s_waitcnt vmcnt(0)" ::: "memory");
        }
    }
    __syncthreads();
}

namespace pg8 {
constexpr int BM = 256, BK = 64, HALF = 128, HTB = HALF * BK * 2, STAGE_BYTES = 8 * HTB, NXCD = 8, WGM = 8;
DI int lds_byte(int r, int c) { const int st = (r >> 4) * 2 + (c >> 5), rr = r & 15, cc = c & 31, ob = rr * 64 + cc * 2; return st * 1024 + (ob ^ (((ob >> 9) & 1) << 5)); }
DI void stage_rc(int b, int& R, int& C) { const int st = b / 1024, sb = b % 1024, swz = sb ^ (((sb >> 9) & 1) << 5); R = (st >> 1) * 16 + swz / 64; C = (st & 1) * 32 + (swz % 64) / 2; }
DI int perm32(int rho) { const int n = rho >> 4, i = rho & 15; return 8 * (i >> 2) + 4 * n + (i & 3); }

struct Unit { int pm, pn, e; const char* A; const char* B; };

struct DenseOrder {
    int nM, nN, nwg, G, c; const char* A; const char* Bt; size_t tstepA, tstepB;
    DI void init(const bf16* A_, int lda, const bf16* Bt_, int ldb, int M, int N, int G_, int c_) { nM = M / BM; nN = N / BM; nwg = nM * nN; G = G_; c = c_; A = (const char*)A_; Bt = (const char*)Bt_; tstepA = (size_t)BM * lda * 2; tstepB = (size_t)BM * ldb * 2; }
    DI bool next(int i, Unit& u) const {
        const long L = (long)i * G + c; if (L >= nwg) return false;
        int wgid = (int)L; { const int q = nwg / NXCD, r = nwg % NXCD, xcd = wgid % NXCD, off = wgid / NXCD; wgid = (xcd < r ? xcd * (q + 1) : r * (q + 1) + (xcd - r) * q) + off; }
        const int nig = WGM * nN, gid = wgid / nig, fm = gid * WGM, gsz = (nM - fm) < WGM ? (nM - fm) : WGM;
        u.pm = fm + ((wgid % nig) % gsz); u.pn = (wgid % nig) / gsz; u.e = 0;
        u.A = A + (size_t)u.pm * tstepA; u.B = Bt + (size_t)u.pn * tstepB; return true;
    }
};
struct MoeOrder {
    int nN, nunits, G, c; const char* A; const char* W; size_t estride; const int* tile_e;
    DI void init(const bf16* A_, const bf16* W_, int Nexp, const int* tile_e_, int nmt, int G_, int c_) { nN = Nexp / BM; nunits = nmt * nN; G = G_; c = c_; A = (const char*)A_; W = (const char*)W_; estride = (size_t)Nexp * 1024 * 2; tile_e = tile_e_; }
    DI bool next(int i, Unit& u) const {
        const long L = (long)i * G + c; if (L >= nunits) return false;
        const int l = (int)L; u.pm = l / nN; u.pn = l % nN;
        u.e = (int)__hip_atomic_load((const unsigned*)tile_e + u.pm, __ATOMIC_RELAXED, __HIP_MEMORY_SCOPE_AGENT) & 31;
        u.A = A + (size_t)u.pm * (BM * 1024 * 2); u.B = W + (size_t)u.e * estride + (size_t)u.pn * (BM * 1024 * 2); return true;
    }
};

DI unsigned cvt_pk_bf16(float lo, float hi) { unsigned r; asm volatile("v_cvt_pk_bf16_f32 %0, %1, %2" : "=v"(r) : "v"(lo), "v"(hi)); return r; }

struct EpiF32 {
    static constexpr bool PERM = false;
    float* C; int ldc;
    DI void operator()(f32x4 (&acc)[2][2][4][2], const Unit& u, int wr, int wc, int fr, int fq) const {
        const int row0 = u.pm * BM + wr * 64 + fr, col0 = u.pn * BM + wc * 32 + 4 * fq;
#pragma unroll
        for (int ai = 0; ai < 2; ++ai)
#pragma unroll
            for (int m = 0; m < 4; ++m) { float* rowp = C + (size_t)(row0 + ai * HALF + m * 16) * ldc + col0;
#pragma unroll
                for (int bj = 0; bj < 2; ++bj)
#pragma unroll
                    for (int n = 0; n < 2; ++n) *(f32x4*)(rowp + bj * HALF + n * 16) = acc[ai][bj][m][n]; }
    }
};
struct EpiBf16 {
    static constexpr bool PERM = true;
    bf16* O; int ldc; const float* bias; int bias_estride; float scale;
    DI void operator()(f32x4 (&acc)[2][2][4][2], const Unit& u, int wr, int wc, int fr, int fq) const {
        const int row0 = u.pm * BM + wr * 64 + fr, col0 = u.pn * BM + wc * 32 + 8 * fq;
        f32x4 bv[2][2];
#pragma unroll
        for (int bj = 0; bj < 2; ++bj)
#pragma unroll
            for (int n = 0; n < 2; ++n) bv[bj][n] = bias ? *(const f32x4*)(bias + (size_t)u.e * bias_estride + col0 + bj * HALF + 4 * n) : (f32x4){0.f, 0.f, 0.f, 0.f};
#pragma unroll
        for (int ai = 0; ai < 2; ++ai)
#pragma unroll
            for (int m = 0; m < 4; ++m) { bf16* rowp = O + (size_t)(row0 + ai * HALF + m * 16) * ldc + col0;
#pragma unroll
                for (int bj = 0; bj < 2; ++bj) { const f32x4 v0 = acc[ai][bj][m][0] * scale + bv[bj][0], v1 = acc[ai][bj][m][1] * scale + bv[bj][1];
                    u32x4 w; w.x = cvt_pk_bf16(v0[0], v0[1]); w.y = cvt_pk_bf16(v0[2], v0[3]); w.z = cvt_pk_bf16(v1[0], v1[1]); w.w = cvt_pk_bf16(v1[2], v1[3]);
                    *(u32x4*)(rowp + bj * HALF) = w; } }
    }
};
struct EpiSwiglu {
    static constexpr bool PERM = true;
    bf16* O; const float* bias;
    DI void operator()(f32x4 (&acc)[2][2][4][2], const Unit& u, int wr, int wc, int fr, int fq) const {
        const int row0 = u.pm * BM + wr * 64 + fr, cw = u.pn * HALF + wc * 32 + 8 * fq;
        const float* bb = bias + (size_t)u.e * 2048 + cw;
        f32x4 bg[2], bu[2];
#pragma unroll
        for (int n = 0; n < 2; ++n) { bg[n] = *(const f32x4*)(bb + 4 * n); bu[n] = *(const f32x4*)(bb + 1024 + 4 * n); }
#pragma unroll
        for (int ai = 0; ai < 2; ++ai)
#pragma unroll
            for (int m = 0; m < 4; ++m) {
                float r[8];
#pragma unroll
                for (int n = 0; n < 2; ++n)
#pragma unroll
                    for (int j = 0; j < 4; ++j) {
                        const float g = fminf(acc[ai][0][m][n][j] + bg[n][j], 7.0f);
                        const float up = fminf(fmaxf(acc[ai][1][m][n][j] + bu[n][j], -7.0f), 7.0f);
                        r[n * 4 + j] = (up + 1.0f) * (g / (1.0f + __expf(-1.702f * g)));
                    }
                u32x4 w; w.x = cvt_pk_bf16(r[0], r[1]); w.y = cvt_pk_bf16(r[2], r[3]); w.z = cvt_pk_bf16(r[4], r[5]); w.w = cvt_pk_bf16(r[6], r[7]);
                *(u32x4*)(O + (size_t)(row0 + ai * HALF + m * 16) * 1024 + cw) = w;
            }
    }
};


struct EpiSoftmax {
    static constexpr bool PERM = true;
    bf16* P; LAS float* X;
    DI void operator()(f32x4 (&acc)[2][2][4][2], const Unit& u, int wr, int wc, int fr, int fq) const {
        float mw[2][4];
#pragma unroll
        for (int ai = 0; ai < 2; ++ai)
#pragma unroll
            for (int m = 0; m < 4; ++m) {
                float mx = -3.0e38f;
#pragma unroll
                for (int bj = 0; bj < 2; ++bj)
#pragma unroll
                    for (int n = 0; n < 2; ++n)
#pragma unroll
                        for (int j = 0; j < 4; ++j) mx = fmaxf(mx, acc[ai][bj][m][n][j]);
                mx = fmaxf(mx, __shfl_xor(mx, 16)); mx = fmaxf(mx, __shfl_xor(mx, 32));
                float sm = 0.f;
#pragma unroll
                for (int bj = 0; bj < 2; ++bj)
#pragma unroll
                    for (int n = 0; n < 2; ++n)
#pragma unroll
                        for (int j = 0; j < 4; ++j) { const float e = __expf(acc[ai][bj][m][n][j] - mx); acc[ai][bj][m][n][j] = e; sm += e; }
                sm += __shfl_xor(sm, 16); sm += __shfl_xor(sm, 32);
                mw[ai][m] = mx;
                if (fq == 0) { LAS f32x2* xp = (LAS f32x2*)X + (ai * HALF + wr * 64 + m * 16 + fr) * 4 + wc; *xp = (f32x2){mx, sm}; }
                __builtin_amdgcn_sched_barrier(0);
            }
        asm volatile("s_waitcnt lgkmcnt(0)" ::: "memory"); __builtin_amdgcn_s_barrier(); asm volatile("" ::: "memory");
#pragma unroll
        for (int ai = 0; ai < 2; ++ai)
#pragma unroll
            for (int m = 0; m < 4; ++m) {
                const int row = ai * HALF + wr * 64 + m * 16 + fr;
                const f32x4 a = *(const LAS f32x4*)(X + row * 8), b = *(const LAS f32x4*)(X + row * 8 + 4);
                const float M = fmaxf(fmaxf(a[0], a[2]), fmaxf(b[0], b[2]));
                const float L = a[1] * __expf(a[0] - M) + a[3] * __expf(a[2] - M) + b[1] * __expf(b[0] - M) + b[3] * __expf(b[2] - M);
                const float f = __expf(mw[ai][m] - M) / L;
                bf16* rowp = P + ((size_t)u.pm * BM + row) * 256 + wc * 32 + 8 * fq;
#pragma unroll
                for (int bj = 0; bj < 2; ++bj) { const f32x4 v0 = acc[ai][bj][m][0] * f, v1 = acc[ai][bj][m][1] * f;
                    u32x4 w; w.x = cvt_pk_bf16(v0[0], v0[1]); w.y = cvt_pk_bf16(v0[2], v0[3]); w.z = cvt_pk_bf16(v1[0], v1[1]); w.w = cvt_pk_bf16(v1[2], v1[3]);
                    *(u32x4*)(rowp + bj * HALF) = w; }
                __builtin_amdgcn_sched_barrier(0);
            }
    }
};

struct EpiCmpH1 {
    static constexpr bool PERM = true;
    bf16* H; const float* bp;
    DI void operator()(f32x4 (&acc)[2][2][4][2], const Unit& u, int wr, int wc, int fr, int fq) const {
        const int row0 = u.pm * BM + wr * 64 + fr, col0 = wc * 32 + 8 * fq;
#pragma unroll
        for (int ai = 0; ai < 2; ++ai)
#pragma unroll
            for (int m = 0; m < 4; ++m) { bf16* rowp = H + (size_t)(row0 + ai * HALF + m * 16) * 256 + col0;
#pragma unroll
                for (int bj = 0; bj < 2; ++bj) { float r[8];
#pragma unroll
                    for (int n = 0; n < 2; ++n)
#pragma unroll
                        for (int j = 0; j < 4; ++j) { const float x = acc[ai][bj][m][n][j] + bp[u.e * 256 + col0 + bj * HALF + 4 * n + j]; const float t = 0.7978845608028654f * (x + 0.044715f * x * x * x);
                            const float e2 = __expf(2.0f * t); r[n * 4 + j] = 0.5f * x * (1.0f + (1.0f - 2.0f / (e2 + 1.0f))); }
                    u32x4 w; w.x = cvt_pk_bf16(r[0], r[1]); w.y = cvt_pk_bf16(r[2], r[3]); w.z = cvt_pk_bf16(r[4], r[5]); w.w = cvt_pk_bf16(r[6], r[7]);
                    *(u32x4*)(rowp + bj * HALF) = w; } }
    }
};
struct CmpH1Order { int G, c; const char* KC; const char* VC; const char* W1T;
    DI bool next(int i, Unit& u) const { const int L = i * G + c; if (L >= 32) return false; const int kv = L >> 4, bg = L & 15; u.pm = L; u.pn = 0; u.e = kv;
        u.A = (kv ? VC : KC) + (size_t)bg * 4096 * 64 * 2; u.B = W1T + (size_t)kv * 256 * 2048 * 2; return true; } };
struct EpiCmpOut {
    static constexpr bool PERM = true;
    bf16* KC; bf16* VCT;
    DI void operator()(f32x4 (&acc)[2][2][4][2], const Unit& u, int wr, int wc, int fr, int fq) const {
        if (wc >= 2) return;
        const int bg = u.pm & 15, d0 = wc * 32 + 8 * fq;
#pragma unroll
        for (int ai = 0; ai < 2; ++ai)
#pragma unroll
            for (int m = 0; m < 4; ++m) { const int cidx = ai * HALF + wr * 64 + m * 16 + fr; const bool pad = (cidx == 255);
                float r[8];
#pragma unroll
                for (int n = 0; n < 2; ++n)
#pragma unroll
                    for (int j = 0; j < 4; ++j) r[n * 4 + j] = pad ? 0.f : acc[ai][0][m][n][j];
                if (u.e == 0) { u32x4 w; w.x = cvt_pk_bf16(r[0], r[1]); w.y = cvt_pk_bf16(r[2], r[3]); w.z = cvt_pk_bf16(r[4], r[5]); w.w = cvt_pk_bf16(r[6], r[7]);
                    *(u32x4*)(KC + ((size_t)bg * 256 + cidx) * 64 + d0) = w; }
                else {
#pragma unroll
                    for (int e = 0; e < 8; ++e) VCT[((size_t)bg * 64 + d0 + e) * 256 + cidx] = (bf16)(cvt_pk_bf16(r[e], 0.f) & 0xffffu); }
            }
    }
};
struct CmpH2Order { int G, c; const char* H; const char* W2T;
    DI bool next(int i, Unit& u) const { const int L = i * G + c; if (L >= 32) return false; const int kv = L >> 4; u.pm = L; u.pn = 0; u.e = kv;
        u.A = H + (size_t)L * 256 * 256 * 2; u.B = W2T + (size_t)kv * 256 * 256 * 2; return true; } };
struct XattnSOrder {
    int G, c; const char* XQ; const char* XK;
    DI bool next(int i, Unit& u) const {
        const int L = i * G + c; if (L >= 512) return false;
        const int qt = L & 15, h = (L >> 4) & 3, b = L >> 6;
        u.pm = L; u.pn = 0; u.e = 0;
        u.A = XQ + ((size_t)(b * 4096 + qt * 256) * 1024 + h * 256) * 2; u.B = XK + ((size_t)(b * 256) * 1024 + h * 256) * 2; return true;
    }
};
struct XattnOOrder {
    int G, c; const char* P; const char* VT;
    DI bool next(int i, Unit& u) const {
        const int L = i * G + c; if (L >= 512) return false;
        const int qt = L & 15, h = (L >> 4) & 3, b = L >> 6;
        u.pm = b * 16 + qt; u.pn = h; u.e = 0;
        u.A = P + (size_t)L * 256 * 256 * 2; u.B = VT + ((size_t)(h * 256) * 2048 + b * 256) * 2; return true;
    }
};

template <class Epi, class Sched>
DI void gemm_phase(LAS unsigned char* lds, const int lda, const int ldb, const int K, const Sched& S, const Epi& E) {
    const int tid = threadIdx.x, wid = __builtin_amdgcn_readfirstlane(tid >> 6), lane = tid & 63, wr = wid >> 2, wc = wid & 3, fr = lane & 15, fq = lane >> 4;
    const int nt = K / BK;
    unsigned voffA[2], voffB[2];
#pragma unroll
    for (int i = 0; i < 2; ++i) { int R, C; stage_rc(tid * 16 + i * 8192, R, C); const int Rb = Epi::PERM ? ((R & ~31) + perm32(R & 31)) : R;
        voffA[i] = (unsigned)(R * lda + C) * 2u; voffB[i] = (unsigned)(Rb * ldb + C) * 2u; }
    const size_t kstep = (size_t)(BK * 2);
    const size_t hstepA = (size_t)HALF * lda * 2, hstepB = (size_t)HALF * ldb * 2;
    const unsigned ldsw = (unsigned)wid * 1024u;
    const int aoff = lds_byte(wr * 64 + fr, fq * 8), boff = lds_byte(wc * 32 + fr, fq * 8);
#define PG8_SA(b, h) (((b) * 2 + (h)) * HTB)
#define PG8_SB(b, h) ((4 + (b) * 2 + (h)) * HTB)
#define PG8_STAGE(bufoff, gbase, voff) do { _Pragma("unroll") for (int _i = 0; _i < 2; ++_i) \
        __builtin_amdgcn_global_load_lds((const unsigned*)((const char*)(gbase) + (voff)[_i]), (LAS unsigned*)(lds + (bufoff) + ldsw + _i * 8192), 16, 0, 0); } while (0)
#define PG8_LDA(dst, b, h) do { _Pragma("unroll") for (int m = 0; m < 4; ++m) _Pragma("unroll") for (int k = 0; k < 2; ++k) dst[m][k] = *(const LAS bf16x8*)(lds + PG8_SA(b, h) + aoff + m * 2048 + k * 1024); } while (0)
#define PG8_LDB(dst, b, h) do { _Pragma("unroll") for (int n = 0; n < 2; ++n) _Pragma("unroll") for (int k = 0; k < 2; ++k) dst[n][k] = *(const LAS bf16x8*)(lds + PG8_SB(b, h) + boff + n * 2048 + k * 1024); } while (0)
#define PG8_MMA(ai, bj, At, Bt) do { __builtin_amdgcn_s_setprio(1); _Pragma("unroll") for (int m = 0; m < 4; ++m) _Pragma("unroll") for (int n = 0; n < 2; ++n) _Pragma("unroll") for (int k = 0; k < 2; ++k) \
        acc[ai][bj][m][n] = __builtin_amdgcn_mfma_f32_16x16x32_bf16(Bt[n][k], At[m][k], acc[ai][bj][m][n], 0, 0, 0); __builtin_amdgcn_s_setprio(0); } while (0)
#define PG8_WAIT_V(n) asm volatile("s_waitcnt vmcnt(" #n ")" ::: "memory")
#define PG8_WAIT_L(n) asm volatile("s_waitcnt lgkmcnt(" #n ")" ::: "memory")
#define PG8_BAR __builtin_amdgcn_s_barrier()
#define PG8_SCHED __builtin_amdgcn_sched_barrier(0)
    Unit cur, nxt; int ui = 0;
    if (!S.next(0, cur)) return;
    f32x4 acc[2][2][4][2];
#pragma unroll
    for (int a = 0; a < 2; ++a)
#pragma unroll
        for (int b = 0; b < 2; ++b)
#pragma unroll
            for (int m = 0; m < 4; ++m)
#pragma unroll
                for (int n = 0; n < 2; ++n) acc[a][b][m][n] = (f32x4){0.f, 0.f, 0.f, 0.f};
    bf16x8 At[4][2], B0[2][2], B1[2][2];
    const char* cA = cur.A; const char* cB = cur.B;
    PG8_STAGE(PG8_SB(0, 0), cB, voffB); PG8_STAGE(PG8_SA(0, 0), cA, voffA); PG8_STAGE(PG8_SB(0, 1), cB + hstepB, voffB); PG8_STAGE(PG8_SA(0, 1), cA + hstepA, voffA);
    if (wr == 1) PG8_BAR;
    PG8_WAIT_V(4); PG8_BAR;
    PG8_STAGE(PG8_SB(1, 0), cB + kstep, voffB); PG8_STAGE(PG8_SA(1, 0), cA + kstep, voffA); PG8_STAGE(PG8_SB(1, 1), cB + hstepB + kstep, voffB);
    PG8_WAIT_V(6); PG8_BAR;
    for (;;) {
        const bool has_next = S.next(ui + 1, nxt);
        const char* nA = has_next ? nxt.A : cA; const char* nB = has_next ? nxt.B : cB;
#pragma nounroll
        for (int t = 0; t < nt; t += 2) {
            const bool last = (t == nt - 2);
            const char* a1 = cA + (size_t)(t + 1) * kstep;
            const char* a2 = last ? nA : cA + (size_t)(t + 2) * kstep; const char* b2 = last ? nB : cB + (size_t)(t + 2) * kstep;
            const char* a3 = a2 + kstep; const char* b3 = b2 + kstep;
            PG8_LDB(B0, 0, 0); PG8_SCHED; PG8_LDA(At, 0, 0); PG8_STAGE(PG8_SA(1, 1), a1 + hstepA, voffA);
            PG8_WAIT_L(8); PG8_BAR; PG8_WAIT_L(0); PG8_MMA(0, 0, At, B0); PG8_BAR; PG8_SCHED;
            PG8_LDB(B1, 0, 1); PG8_STAGE(PG8_SB(0, 0), b2, voffB);
            PG8_BAR; PG8_WAIT_L(0); PG8_MMA(0, 1, At, B1); PG8_BAR;
            PG8_LDA(At, 0, 1); PG8_STAGE(PG8_SA(0, 0), a2, voffA);
            PG8_BAR; PG8_WAIT_L(0); PG8_MMA(1, 0, At, B0); PG8_BAR; PG8_SCHED;
            PG8_STAGE(PG8_SB(0, 1), b2 + hstepB, voffB);
            PG8_WAIT_V(6); PG8_BAR; PG8_MMA(1, 1, At, B1); PG8_BAR;
            PG8_LDB(B0, 1, 0); PG8_SCHED; PG8_LDA(At, 1, 0); PG8_STAGE(PG8_SA(0, 1), a2 + hstepA, voffA);
            PG8_WAIT_L(8); PG8_BAR; PG8_WAIT_L(0); PG8_MMA(0, 0, At, B0); PG8_BAR; PG8_SCHED;
            PG8_LDB(B1, 1, 1); PG8_STAGE(PG8_SB(1, 0), b3, voffB);
            PG8_BAR; PG8_WAIT_L(0); PG8_MMA(0, 1, At, B1); PG8_BAR;
            PG8_LDA(At, 1, 1); PG8_STAGE(PG8_SA(1, 0), a3, voffA);
            PG8_BAR; PG8_WAIT_L(0); PG8_MMA(1, 0, At, B0); PG8_BAR; PG8_SCHED;
            PG8_STAGE(PG8_SB(1, 1), b3 + hstepB, voffB);
            PG8_WAIT_V(6); PG8_BAR; PG8_MMA(1, 1, At, B1); PG8_BAR;
        }
        E(acc, cur, wr, wc, fr, fq);
        if (!has_next) break;
#pragma unroll
        for (int a = 0; a < 2; ++a)
#pragma unroll
            for (int b = 0; b < 2; ++b)
#pragma unroll
                for (int m = 0; m < 4; ++m)
#pragma unroll
                    for (int n = 0; n < 2; ++n) acc[a][b][m][n] = (f32x4){0.f, 0.f, 0.f, 0.f};
        cur = nxt; cA = nA; cB = nB; ++ui;
    }
    PG8_WAIT_V(0);
    if (wr == 0) PG8_BAR;
    PG8_BAR;
#undef PG8_SA
#undef PG8_SB
#undef PG8_STAGE
#undef PG8_LDA
#undef PG8_LDB
#undef PG8_MMA
#undef PG8_WAIT_V
#undef PG8_WAIT_L
#undef PG8_BAR
#undef PG8_SCHED
}
}

struct Args { const void* in[29]; float* out; unsigned char* ws; int ph_lo, ph_hi; };

struct Ctx {
    LAS unsigned char* lds; unsigned char* ws; const Args* a;
    int tid, lane, wave, bid, G, gw, NGW;
};
#define WSP(type, off) ((type*)(C.ws + (off)))
#define INP(type, i) ((const type*)(C.a->in[i]))

DI void transpose_item(const float* W, int K, int N, int nblk, bf16* WT, int mode, LAS float* scr, int item, int lane) {
    const int kb = item / nblk, nb = item % nblk, k0 = 64 * kb, n0 = 32 * nb;
    const int n = n0 + (lane & 31); const bool ok = n < N;
#pragma unroll 8
    for (int i = 0; i < 32; ++i) { const int kk = 2 * i + (lane >> 5); scr[kk * 33 + (lane & 31)] = ok ? W[(size_t)(k0 + kk) * N + n] : 0.f; }
    LDS_WAIT();
    const int c = lane & 7;
    int orow0 = n0;
    if (mode == 1) orow0 = (n0 < 1024) ? ((n0 >> 7) * 256 + (n0 & 127)) : ((((n0 - 1024) >> 7) * 256) + 128 + ((n0 - 1024) & 127));
#pragma unroll
    for (int j = 0; j < 4; ++j) { const int nn = (lane >> 3) + 8 * j; const LAS float* s = scr + (8 * c) * 33 + nn;
        u32x4 o; o.x = pk2(s[0 * 33], s[1 * 33]); o.y = pk2(s[2 * 33], s[3 * 33]); o.z = pk2(s[4 * 33], s[5 * 33]); o.w = pk2(s[6 * 33], s[7 * 33]);
        *(u32x4*)(WT + (size_t)(orow0 + nn) * K + k0 + 8 * c) = o; }
    LDS_WAIT();
}

DI void phase_convert(const Ctx& C) {
    LAS float* scr = (LAS float*)(C.lds + C.wave * 16384);
    constexpr int I_EVEN = 16 * (EVEN_PAD / 32), I_ODD = 16 * (ODD_IN / 32), I_SQ = 16 * 32, I_KV = 16 * 64, I_GU = 16 * 64, I_DN = 16 * 32;
    constexpr int NITEMS = I_EVEN + I_ODD + 2 * I_SQ + 2 * I_SQ + 2 * I_KV + 2 * I_SQ + 64 * I_GU + 64 * I_DN;
    for (int it = C.gw; it < NITEMS; it += C.NGW) {
        int r = it;
        if (r < I_EVEN) { transpose_item(INP(float, 3), 1024, EVEN_IN, EVEN_PAD / 32, WSP(bf16, WS_WEVEN), 0, scr, r, C.lane); continue; } r -= I_EVEN;
        if (r < I_ODD) { transpose_item(INP(float, 12), 1024, ODD_IN, ODD_IN / 32, WSP(bf16, WS_WODD), 0, scr, r, C.lane); continue; } r -= I_ODD;
        if (r < I_SQ) { transpose_item(INP(float, 11), 1024, 1024, 32, WSP(bf16, WS_WOUTE), 0, scr, r, C.lane); continue; } r -= I_SQ;
        if (r < I_SQ) { transpose_item(INP(float, 17), 1024, 1024, 32, WSP(bf16, WS_WOUTO), 0, scr, r, C.lane); continue; } r -= I_SQ;
        if (r < 2 * I_SQ) { const int l = r / I_SQ; transpose_item(INP(float, 18) + (size_t)l * 1024 * 1024, 1024, 1024, 32, WSP(bf16, WS_WXQ) + (size_t)l * 1024 * 1024, 0, scr, r % I_SQ, C.lane); continue; } r -= 2 * I_SQ;
        if (r < 2 * I_KV) { const int l = r / I_KV; transpose_item(INP(float, 19) + (size_t)l * 1024 * 2048, 1024, 2048, 64, WSP(bf16, WS_WXKV) + (size_t)l * 2048 * 1024, 0, scr, r % I_KV, C.lane); continue; } r -= 2 * I_KV;
        if (r < 2 * I_SQ) { const int l = r / I_SQ; transpose_item(INP(float, 20) + (size_t)l * 1024 * 1024, 1024, 1024, 32, WSP(bf16, WS_WXO) + (size_t)l * 1024 * 1024, 0, scr, r % I_SQ, C.lane); continue; } r -= 2 * I_SQ;
        if (r < 64 * I_GU) { const int le = r / I_GU; transpose_item(INP(float, 25) + (size_t)le * 1024 * 2048, 1024, 2048, 64, WSP(bf16, WS_WGU) + (size_t)le * 2048 * 1024, 1, scr, r % I_GU, C.lane); continue; } r -= 64 * I_GU;
        { const int le = r / I_DN; transpose_item(INP(float, 27) + (size_t)le * 1024 * 1024, 1024, 1024, 32, WSP(bf16, WS_WDN) + (size_t)le * 1024 * 1024, 0, scr, r % I_DN, C.lane); }
    }
    for (int it = C.gw; it < 2 * 256 + 2 * 32; it += C.NGW) {
        if (it < 512) { const int kv = it >> 8; transpose_item(INP(float, 5) + (size_t)kv * 2048 * 256, 2048, 256, 8, WSP(bf16, WS_W1T) + (size_t)kv * 256 * 2048, 0, scr, it & 255, C.lane); }
        else { const int r = it - 512, kv = r >> 5; transpose_item(INP(float, 6) + (size_t)kv * 256 * 64, 256, 64, 8, WSP(bf16, WS_W2T) + (size_t)kv * 256 * 256, 0, scr, r & 31, C.lane); }
    }
    for (int it = C.gw; it < 512; it += C.NGW) { const int kv = it >> 8, j = it & 255; const float* pos = INP(float, 4) + kv * 2048; const float* w1 = INP(float, 5) + (size_t)kv * 2048 * 256 + j;
        float acc = 0.f; for (int k = C.lane; k < 2048; k += 64) acc += pos[k] * w1[(size_t)k * 256]; acc = wave_sum(acc); if (C.lane == 0) WSP(float, WS_BP)[it] = acc; }
    { const float* sw = INP(float, 9); bf16* o = WSP(bf16, WS_SGW);
      for (int i = C.bid * NTHREADS + C.tid; i < 4 * 128 * 128; i += C.G * NTHREADS) { const int s2 = i & 127, tt = (i >> 7) & 127; o[i] = (bf16)(s2 <= tt ? f2bf(sw[i]) : 0u); } }
    const size_t gt = (size_t)C.bid * NTHREADS + C.tid, ngt = (size_t)C.G * NTHREADS;
    { const f32x4* x4 = INP(f32x4, 0); u32x2* o = WSP(u32x2, WS_XB);
      for (size_t i = gt; i < (size_t)T * DM / 4; i += ngt) { const f32x4 v = x4[i]; u32x2 w; w.x = pk2(v[0], v[1]); w.y = pk2(v[2], v[3]); o[i] = w; } }
    { const f32x4* x4 = INP(f32x4, 1); u32x2* o = WSP(u32x2, WS_MEMB);
      for (size_t i = gt; i < (size_t)NB * 256 * DM / 4; i += ngt) { const f32x4 v = x4[i]; u32x2 w; w.x = pk2(v[0], v[1]); w.y = pk2(v[2], v[3]); o[i] = w; } }
    { const int* pos = INP(int, 2); float* rc = WSP(float, WS_ROPEC); float* rs = WSP(float, WS_ROPES);
      for (size_t i = gt; i < (size_t)T * 32; i += ngt) { const int t = (int)(i >> 5), d = (int)(i & 31);
          const double inv = exp2(-(double)d * (13.287712379549449 / 32.0));
          const double ang = (double)pos[t] * inv;
          rc[i] = (float)cos(ang); rs[i] = (float)sin(ang); } }
}

DI void phase_nsa_prep(const Ctx& C) {
    const bf16* PROJ = WSP(bf16, R_PROJ); const float* RC = WSP(float, WS_ROPEC); const float* RS = WSP(float, WS_ROPES);
    bf16* QN = WSP(bf16, R_QN); bf16* QR = WSP(bf16, R_QR);
    bf16* KV6[6] = {WSP(bf16, R_KCMP), WSP(bf16, R_VCMP), WSP(bf16, R_KSLC), WSP(bf16, R_VSLC), WSP(bf16, R_KWIN), WSP(bf16, R_VWIN)};
    float* GATES = WSP(float, R_GATES); bf16* UG = WSP(bf16, R_UG); bf16* VN = WSP(bf16, R_VN);
    const float* lng = INP(float, 7); const float* lnb = INP(float, 8);
    const int lane = C.lane;
    for (int t = C.gw; t < T; t += C.NGW) {
        const bf16* pr = PROJ + (size_t)t * EVEN_PAD;
        const int b = t / SEQ, s = t % SEQ;
        const float cs = RC[(size_t)t * 32 + (lane & 31)], sn = RS[(size_t)t * 32 + (lane & 31)];
#pragma unroll
        for (int h = 0; h < 8; ++h) {
            const bf16 raw = pr[h * 64 + lane]; const float v = bf2f(raw); const float pv = __shfl_xor(v, 32);
            const float r = (lane < 32) ? (v * cs - pv * sn) : (v * cs + pv * sn);
            QN[(size_t)t * 512 + h * 64 + lane] = (bf16)f2bf(v * 0.125f); QR[(size_t)t * 512 + h * 64 + lane] = (bf16)f2bf(r * 0.125f);
        }
#pragma unroll
        for (int i = 0; i < 6; ++i)
#pragma unroll
            for (int g = 0; g < 2; ++g) {
                const bf16 raw = pr[512 + i * 128 + g * 64 + lane]; bf16 o = raw;
                if (i == 2 || i == 4) { const float v = bf2f(raw); const float pv = __shfl_xor(v, 32); const float r = (lane < 32) ? (v * cs - pv * sn) : (v * cs + pv * sn); o = (bf16)f2bf(r); }
                if (i == 3 || i == 5) KV6[i][((size_t)(b * 2 + g) * 64 + lane) * SEQ + s] = o;
                else KV6[i][((size_t)(b * 2 + g) * SEQ + s) * 64 + lane] = o;
            }
        if (lane < 24) GATES[(size_t)t * 24 + lane] = sigmoidf(bf2f(pr[1280 + lane]));
#pragma unroll
        for (int j = 0; j < 8; ++j) { const int c = lane + 64 * j; UG[(size_t)t * 512 + c] = (bf16)f2bf(gelu_tanh(bf2f(pr[1304 + c]))); }
#pragma unroll
        for (int g = 0; g < 4; ++g) {
            const float a0 = gelu_tanh(bf2f(pr[1816 + g * 128 + lane])), a1 = gelu_tanh(bf2f(pr[1816 + g * 128 + 64 + lane]));
            const float mean = wave_sum(a0 + a1) * (1.0f / 128.0f); const float d0 = a0 - mean, d1 = a1 - mean;
            const float var = wave_sum(d0 * d0 + d1 * d1) * (1.0f / 128.0f); const float rstd = 1.0f / sqrtf(var + 1e-5f);
            VN[((size_t)b * 512 + g * 128 + lane) * SEQ + s] = (bf16)f2bf(d0 * rstd * lng[g * 128 + lane] + lnb[g * 128 + lane]);
            VN[((size_t)b * 512 + g * 128 + 64 + lane) * SEQ + s] = (bf16)f2bf(d1 * rstd * lng[g * 128 + 64 + lane] + lnb[g * 128 + 64 + lane]);
        }
    }
}

template <int D, int NH>
DI void wave_attn_blocks(const LAS float* qs, const bf16* Kb, size_t kstride, const bf16* Vb, size_t vstride, u64 blkmask, int spos, int window,
                         float (&o)[NH][D / 64], float (&m)[NH], float (&l)[NH], int lane) {
    while (blkmask) {
        const int j = __builtin_ctzll(blkmask); blkmask &= blkmask - 1;
        const int key = 64 * j + lane; const bool valid = (key <= spos) && (spos - key < window);
        const bf16* kr = Kb + (size_t)key * kstride;
        float sc[NH];
#pragma unroll
        for (int h = 0; h < NH; ++h) sc[h] = 0.f;
#pragma unroll 2
        for (int d0 = 0; d0 < D; d0 += 8) {
            const bf16x8 kk = *(const bf16x8*)(kr + d0);
#pragma unroll
            for (int h = 0; h < NH; ++h) { const f32x4 q0 = *(const LAS f32x4*)(qs + h * D + d0), q1 = *(const LAS f32x4*)(qs + h * D + d0 + 4);
#pragma unroll
                for (int e = 0; e < 8; ++e) sc[h] += (e < 4 ? q0[e] : q1[e - 4]) * bf2f((bf16)kk[e]); }
        }
        float p[NH];
#pragma unroll
        for (int h = 0; h < NH; ++h) {
            const float sv = valid ? sc[h] : -1e30f; const float bm = wave_max(sv); const float mn = fmaxf(m[h], bm);
            const float corr = __expf(m[h] - mn); p[h] = valid ? __expf(sc[h] - mn) : 0.f;
            l[h] = l[h] * corr + wave_sum(p[h]); m[h] = mn;
#pragma unroll
            for (int r = 0; r < D / 64; ++r) o[h][r] *= corr;
        }
#pragma unroll 4
        for (int i = 0; i < 64; ++i) {
            const bf16* vr = Vb + (size_t)(64 * j + i) * vstride + lane;
            float vv[D / 64];
#pragma unroll
            for (int r = 0; r < D / 64; ++r) vv[r] = bf2f(vr[64 * r]);
#pragma unroll
            for (int h = 0; h < NH; ++h) { const float pi = rdlane(p[h], i);
#pragma unroll
                for (int r = 0; r < D / 64; ++r) o[h][r] += pi * vv[r]; }
        }
    }
}

constexpr int NSA_KS = 72, NSA_VS = 68;
constexpr int NSA_K0 = 0, NSA_K1 = 9216, NSA_V0 = 18432, NSA_V1 = 27136, NSA_IMP = 36864, NSA_TMASK = 53248, NSA_WUN = 53760;
typedef float f32x16 __attribute__((ext_vector_type(16)));
DI int crow16(int reg, int h2) { return (reg & 3) + 8 * (reg >> 2) + 4 * h2; }
template <bool NEEDV> DI void nsa_ld(u32x4& kr, u32x4& vr, const bf16* Kg, const bf16* Vg, size_t ldv, int tid) {
    const int row = tid >> 3, ch = tid & 7;
    kr = *(const u32x4*)(Kg + row * 64 + ch * 8);
    if (NEEDV) vr = *(const u32x4*)(Vg + (size_t)row * ldv + ch * 8);
}
template <bool NEEDV> DI void nsa_st(LAS bf16* Kb, LAS bf16* Vb, const u32x4& kr, const u32x4& vr, int tid) {
    const int row = tid >> 3, ch = tid & 7;
    *(LAS u32x4*)(Kb + row * NSA_KS + ch * 8) = kr;
    if (NEEDV) { *(LAS u32x2*)(Vb + row * NSA_VS + ch * 8) = (u32x2){vr.x, vr.y}; *(LAS u32x2*)(Vb + row * NSA_VS + ch * 8 + 4) = (u32x2){vr.z, vr.w}; }
}
DI void nsa_scores(const LAS bf16* Kb, const bf16x8 (&qf)[4], f32x16 (&S)[2], int r32, int h2) {
#pragma unroll
    for (int kb = 0; kb < 2; ++kb) {
        f32x16 acc;
#pragma unroll
        for (int i = 0; i < 16; ++i) acc[i] = 0.f;
#pragma unroll
        for (int ks = 0; ks < 4; ++ks) { const bf16x8 a = *(const LAS bf16x8*)(Kb + (32 * kb + r32) * NSA_KS + 16 * ks + 8 * h2); acc = __builtin_amdgcn_mfma_f32_32x32x16_bf16(a, qf[ks], acc, 0, 0, 0); }
        S[kb] = acc;
    }
}
DI void nsa_tile_online(const LAS bf16* Kb, const LAS bf16* Vb, const bf16x8 (&qf)[4], bool en, int klo, int khi, float& m, float& l, f32x16 (&O)[2], int r32, int h2) {
    f32x16 S[2]; nsa_scores(Kb, qf, S, r32, h2);
    const bool full = __all(en && klo <= 0 && khi >= 63);
    if (!full) {
#pragma unroll
        for (int kb = 0; kb < 2; ++kb)
#pragma unroll
            for (int r = 0; r < 16; ++r) { const int kk = 32 * kb + crow16(r, h2); const bool ok = en && kk >= klo && kk <= khi; S[kb][r] = ok ? S[kb][r] : -1e30f; }
    }
    float mx = -1e30f;
#pragma unroll
    for (int kb = 0; kb < 2; ++kb)
#pragma unroll
        for (int r = 0; r < 16; ++r) mx = fmaxf(mx, S[kb][r]);
    mx = fmaxf(mx, __shfl_xor(mx, 32));
    const float mn = fmaxf(m, mx), corr = __expf(m - mn), mref = fmaxf(mn, -1e29f);
    float ls = 0.f;
#pragma unroll
    for (int kb = 0; kb < 2; ++kb)
#pragma unroll
        for (int r = 0; r < 16; ++r) { const float p = __expf(S[kb][r] - mref); S[kb][r] = p; ls += p; }
    ls += __shfl_xor(ls, 32);
    l = l * corr + ls; m = mn;
#pragma unroll
    for (int i = 0; i < 2; ++i)
#pragma unroll
        for (int r = 0; r < 16; ++r) O[i][r] *= corr;
#pragma unroll
    for (int st = 0; st < 4; ++st) {
        const int kb = st >> 1, r0 = 8 * (st & 1);
        u32x4 pk; pk.x = pg8::cvt_pk_bf16(S[kb][r0], S[kb][r0 + 1]); pk.y = pg8::cvt_pk_bf16(S[kb][r0 + 2], S[kb][r0 + 3]); pk.z = pg8::cvt_pk_bf16(S[kb][r0 + 4], S[kb][r0 + 5]); pk.w = pg8::cvt_pk_bf16(S[kb][r0 + 6], S[kb][r0 + 7]);
        const bf16x8 pb = __builtin_bit_cast(bf16x8, pk);
#pragma unroll
        for (int i = 0; i < 2; ++i) {
            const LAS bf16* vp = Vb + (32 * i + r32) * NSA_VS + 16 * st + 4 * h2;
            const u32x2 lo = *(const LAS u32x2*)vp, hi = *(const LAS u32x2*)(vp + 8);
            const bf16x8 va = __builtin_bit_cast(bf16x8, (u32x4){lo.x, lo.y, hi.x, hi.y});
            O[i] = __builtin_amdgcn_mfma_f32_32x32x16_bf16(va, pb, O[i], 0, 0, 0);
        }
    }
}
DI void nsa_tile_imp(const LAS bf16* Kb, const bf16x8 (&qf)[4], int khi, float m, float invl, LAS float* improw, int jbase, int r32, int h2) {
    f32x16 S[2]; nsa_scores(Kb, qf, S, r32, h2);
    const float mref = fmaxf(m, -1e29f);
#pragma unroll
    for (int kb = 0; kb < 2; ++kb)
#pragma unroll
        for (int rg = 0; rg < 4; ++rg) {
            float p[4];
#pragma unroll
            for (int e = 0; e < 4; ++e) { const int kk = 32 * kb + 8 * rg + 4 * h2 + e; p[e] = (kk <= khi) ? __expf(S[kb][4 * rg + e] - mref) * invl : 0.f; }
            float a = p[0] + p[1] + p[2] + 0.5f * p[3], c = 0.5f * p[3];
            a += __shfl_xor(a, 1); a += __shfl_xor(a, 2); c += __shfl_xor(c, 1); c += __shfl_xor(c, 2);
            if ((r32 & 3) == 0) { const int j = jbase + 8 * kb + 2 * rg + h2;
                __hip_atomic_fetch_add(improw + j, a, __ATOMIC_RELAXED, __HIP_MEMORY_SCOPE_WORKGROUP);
                if (j < 63) __hip_atomic_fetch_add(improw + j + 1, c, __ATOMIC_RELAXED, __HIP_MEMORY_SCOPE_WORKGROUP); }
        }
}
template <int MODE>
DI void nsa_branch(LAS unsigned char* lds, u64 list, const bf16* Kg0, const bf16* Vg0, size_t ldv, const bf16x8 (&qf)[4], int tpos, int cmax, u64 mymask, u64 wun,
                   float& m, float& l, f32x16 (&O)[2], LAS float* improw, int tid, int r32, int h2) {
    constexpr bool NEEDV = (MODE != 1);
    if (list == 0) return;
    u32x4 kr, vr; vr = (u32x4){0u, 0u, 0u, 0u};
    int j = __builtin_ctzll(list); u64 rem = list & (list - 1); int idx = 0;
    nsa_ld<NEEDV>(kr, vr, Kg0 + (size_t)j * 4096, Vg0 + (size_t)j * 64, ldv, tid);
    nsa_st<NEEDV>((LAS bf16*)(lds + NSA_K0), (LAS bf16*)(lds + NSA_V0), kr, vr, tid);
    __syncthreads();
    const float invl = (MODE == 1 && l > 0.f) ? 1.0f / l : 0.f;
    for (;;) {
        const bool hasnext = rem != 0; const int jn = hasnext ? __builtin_ctzll(rem) : 0;
        if (hasnext) nsa_ld<NEEDV>(kr, vr, Kg0 + (size_t)jn * 4096, Vg0 + (size_t)jn * 64, ldv, tid);
        const LAS bf16* Kb = (const LAS bf16*)(lds + ((idx & 1) ? NSA_K1 : NSA_K0)); const LAS bf16* Vb = (const LAS bf16*)(lds + ((idx & 1) ? NSA_V1 : NSA_V0));
        if (MODE == 0) nsa_tile_online(Kb, Vb, qf, true, 0, cmax - 64 * j, m, l, O, r32, h2);
        if (MODE == 1) nsa_tile_imp(Kb, qf, cmax - 64 * j, m, invl, improw, 16 * j, r32, h2);
        if (MODE == 2) { if ((wun >> j) & 1ull) nsa_tile_online(Kb, Vb, qf, ((mymask >> j) & 1ull) != 0ull, 0, tpos - 64 * j, m, l, O, r32, h2); }
        if (MODE == 3) nsa_tile_online(Kb, Vb, qf, true, tpos - 511 - 64 * j, tpos - 64 * j, m, l, O, r32, h2);
        if (hasnext) nsa_st<NEEDV>((LAS bf16*)(lds + ((idx & 1) ? NSA_K0 : NSA_K1)), (LAS bf16*)(lds + ((idx & 1) ? NSA_V0 : NSA_V1)), kr, vr, tid);
        __syncthreads();
        if (!hasnext) break;
        j = jn; rem &= rem - 1; ++idx;
    }
}
DI void nsa_fold(f32x16 (&res)[2], const f32x16 (&O)[2], float l, float gate) {
    const float f = l > 0.f ? gate / l : 0.f;
#pragma unroll
    for (int i = 0; i < 2; ++i)
#pragma unroll
        for (int r = 0; r < 16; ++r) res[i][r] += f * O[i][r];
}
DI void phase_nsa(const Ctx& C) {
    const int tid = C.tid, lane = C.lane, r32 = lane & 31, h2 = lane >> 5, w = C.wave;
    const bf16* QN = WSP(bf16, R_QN); const bf16* QR = WSP(bf16, R_QR); const float* GATES = WSP(float, R_GATES); bf16* MIXIN = WSP(bf16, WS_MIXIN);
    LAS float* IMP = (LAS float*)(C.lds + NSA_IMP); LAS u64* TMASK = (LAS u64*)(C.lds + NSA_TMASK); LAS u64* WUN = (LAS u64*)(C.lds + NSA_WUN);
    for (int u = C.bid; u < 1024; u += C.G) {
        const int r = u >> 8, cc = u & 255, bg = cc & 15, qslot = cc >> 4;
        const int qb = (r & 1) ? (16 * r + 15 - qslot) : (16 * r + qslot);
        const int b = bg >> 1, g = bg & 1, s0 = 64 * qb;
        const int tl = 8 * w + (r32 >> 2), hh = r32 & 3, tpos = s0 + tl; const size_t t = (size_t)b * SEQ + tpos;
        const int cmax = tpos >= 31 ? ((tpos - 31) >> 4) : -1;
        LAS float* improw = IMP + tl * 64;
        { LAS f32x4* z = (LAS f32x4*)(IMP + 8 * w * 64); z[lane] = (f32x4){0.f, 0.f, 0.f, 0.f}; z[lane + 64] = (f32x4){0.f, 0.f, 0.f, 0.f}; }
        bf16x8 qf[4];
#pragma unroll
        for (int ks = 0; ks < 4; ++ks) qf[ks] = *(const bf16x8*)(QN + t * 512 + (g * 4 + hh) * 64 + 16 * ks + 8 * h2);
        f32x16 res[2], O[2];
#pragma unroll
        for (int i = 0; i < 2; ++i)
#pragma unroll
            for (int k = 0; k < 16; ++k) { res[i][k] = 0.f; O[i][k] = 0.f; }
        float m = -1e30f, l = 0.f;
        const float* gp = GATES + t * 24 + g * 12 + hh * 3;
        const int nct = (4 * qb + 3 + 63) >> 6; const u64 clist = (1ull << nct) - 1ull;
        const bf16* KCb = WSP(bf16, R_KC) + (size_t)bg * 256 * 64; const bf16* VCTb = WSP(bf16, R_VC) + (size_t)bg * 64 * 256;
        nsa_branch<0>(C.lds, clist, KCb, VCTb, 256, qf, tpos, cmax, 0ull, 0ull, m, l, O, improw, tid, r32, h2);
        nsa_fold(res, O, l, gp[0]);
        nsa_branch<1>(C.lds, clist, KCb, VCTb, 256, qf, tpos, cmax, 0ull, 0ull, m, l, O, improw, tid, r32, h2);
        const u64 upto = (qb == 63) ? ~0ull : ((2ull << qb) - 1ull);
        u64 wun = 0ull;
        for (int i = 0; i < 8; ++i) {
            const float sc = IMP[(8 * w + i) * 64 + lane];
            const bool forced = (lane == 0) || (lane == qb) || (lane == qb - 1);
            const float score = forced ? 1e4f : (lane <= qb ? sc : -1.0f);
            int rank = 0;
#pragma unroll 8
            for (int k = 0; k < 64; ++k) { const float sk = rdlane(score, k); rank += (sk > score || (sk == score && k < lane)) ? 1 : 0; }
            const u64 msk = __ballot(rank < 16) & upto;
            if (lane == 0) TMASK[8 * w + i] = msk;
            wun |= msk;
        }
        if (lane == 0) WUN[w] = wun;
        __syncthreads();
        const u64 mymask = TMASK[tl];
        u64 un = 0ull;
#pragma unroll
        for (int i = 0; i < 8; ++i) un |= WUN[i];
        un = ((u64)__builtin_amdgcn_readfirstlane((unsigned)(un >> 32)) << 32) | (u64)__builtin_amdgcn_readfirstlane((unsigned)un);
#pragma unroll
        for (int ks = 0; ks < 4; ++ks) qf[ks] = *(const bf16x8*)(QR + t * 512 + (g * 4 + hh) * 64 + 16 * ks + 8 * h2);
#pragma unroll
        for (int i = 0; i < 2; ++i)
#pragma unroll
            for (int k = 0; k < 16; ++k) O[i][k] = 0.f;
        m = -1e30f; l = 0.f;
        nsa_branch<2>(C.lds, un, WSP(bf16, R_KSLC) + (size_t)bg * SEQ * 64, WSP(bf16, R_VSLC) + (size_t)bg * 64 * SEQ, SEQ, qf, tpos, cmax, mymask, wun, m, l, O, improw, tid, r32, h2);
        nsa_fold(res, O, l, gp[1]);
#pragma unroll
        for (int i = 0; i < 2; ++i)
#pragma unroll
            for (int k = 0; k < 16; ++k) O[i][k] = 0.f;
        m = -1e30f; l = 0.f;
        const int jlo = qb - 8 > 0 ? qb - 8 : 0; const u64 wlist = upto & ~((1ull << jlo) - 1ull);
        nsa_branch<3>(C.lds, wlist, WSP(bf16, R_KWIN) + (size_t)bg * SEQ * 64, WSP(bf16, R_VWIN) + (size_t)bg * 64 * SEQ, SEQ, qf, tpos, cmax, 0ull, 0ull, m, l, O, improw, tid, r32, h2);
        nsa_fold(res, O, l, gp[2]);
        bf16* orow = MIXIN + t * 1024 + (g * 4 + hh) * 64;
#pragma unroll
        for (int i = 0; i < 2; ++i)
#pragma unroll
            for (int rg = 0; rg < 4; ++rg) { u32x2 o2; o2.x = pg8::cvt_pk_bf16(res[i][4 * rg], res[i][4 * rg + 1]); o2.y = pg8::cvt_pk_bf16(res[i][4 * rg + 2], res[i][4 * rg + 3]);
                *(u32x2*)(orow + 32 * i + 8 * rg + 4 * h2) = o2; }
    }
}

DI void phase_sgu(const Ctx& C) {
    const int lane = C.lane, r32 = lane & 31, h2 = lane >> 5, w = C.wave;
    const bf16* SGW = WSP(bf16, WS_SGW); const bf16* VNT = WSP(bf16, R_VN); const bf16* UG = WSP(bf16, R_UG); const float* sb = INP(float, 10); bf16* MIXIN = WSP(bf16, WS_MIXIN);
    for (int unit = C.bid; unit < 1024; unit += C.G) {
        const int g = unit & 3, n = (unit >> 2) & 31, b = unit >> 7;
        const size_t tok0 = (size_t)b * SEQ + n * 128;
#pragma unroll
        for (int rep = 0; rep < 2; ++rep) {
            const int tile = w + 8 * rep, ti = tile >> 2, ci = tile & 3, nks = 2 * ti + 2;
            f32x16 acc;
#pragma unroll
            for (int i = 0; i < 16; ++i) acc[i] = 0.f;
            const bf16* ap = SGW + (size_t)(g * 128 + 32 * ti + r32) * 128 + 8 * h2; const bf16* bp = VNT + ((size_t)b * 512 + g * 128 + 32 * ci + r32) * SEQ + n * 128 + 8 * h2;
            for (int ks = 0; ks < nks; ++ks) { const bf16x8 av = *(const bf16x8*)(ap + 16 * ks), bv = *(const bf16x8*)(bp + 16 * ks); acc = __builtin_amdgcn_mfma_f32_32x32x16_bf16(av, bv, acc, 0, 0, 0); }
            const int cidx = g * 128 + 32 * ci + r32;
#pragma unroll
            for (int rg = 0; rg < 16; ++rg) { const int tt = 32 * ti + crow16(rg, h2); const size_t tok = tok0 + tt;
                MIXIN[tok * 1024 + 512 + cidx] = (bf16)f2bf(bf2f(UG[tok * 512 + cidx]) * (acc[rg] + sb[g * 128 + tt])); }
        }
    }
}

DI void ln_row_finish(f32x4 (&v)[4], const float* gam, const float* bet, float* xo, bf16* xb, int lane) {
    float s = 0.f;
#pragma unroll
    for (int j = 0; j < 4; ++j) s += (v[j][0] + v[j][1]) + (v[j][2] + v[j][3]);
    const float mean = wave_sum(s) * (1.0f / DM); float s2 = 0.f;
#pragma unroll
    for (int j = 0; j < 4; ++j) { v[j] = v[j] - mean; s2 += (v[j][0] * v[j][0] + v[j][1] * v[j][1]) + (v[j][2] * v[j][2] + v[j][3] * v[j][3]); }
    const float rstd = 1.0f / sqrtf(wave_sum(s2) * (1.0f / DM) + 1e-5f);
#pragma unroll
    for (int j = 0; j < 4; ++j) { const f32x4 gg = ((const f32x4*)gam)[lane + 64 * j], bb = ((const f32x4*)bet)[lane + 64 * j];
        const f32x4 r = v[j] * rstd * gg + bb; ((f32x4*)xo)[lane + 64 * j] = r;
        u32x2 w; w.x = pk2(r[0], r[1]); w.y = pk2(r[2], r[3]); ((u32x2*)xb)[lane + 64 * j] = w; }
}
DI void phase_ln(const Ctx& C, const float* xprev, const float* y, const float* gam, const float* bet, float* xnext, bf16* xb) {
    for (int t = C.gw; t < T; t += C.NGW) {
        f32x4 v[4];
#pragma unroll
        for (int j = 0; j < 4; ++j) v[j] = ((const f32x4*)(xprev + (size_t)t * DM))[C.lane + 64 * j] * ALPHA + ((const f32x4*)(y + (size_t)t * DM))[C.lane + 64 * j];
        ln_row_finish(v, gam, bet, xnext + (size_t)t * DM, xb + (size_t)t * DM, C.lane);
    }
}

DI void phase_xattn(const Ctx& C, int layer) {
    const int lane = C.lane;
    LAS float* qs = (LAS float*)(C.lds + C.wave * 16384);
    const bf16* XQ = WSP(bf16, WS_XQ); const bf16* XKV = WSP(bf16, WS_XKV) + (size_t)layer * 2048 * 2048; bf16* XO = WSP(bf16, WS_XO);
    for (int it0 = C.gw; it0 < T * 4; it0 += C.NGW) {
        const int it = __builtin_amdgcn_readfirstlane(it0);
        const int h = it & 3, t = it >> 2, b = t / SEQ;
#pragma unroll
        for (int r = 0; r < 4; ++r) qs[lane + 64 * r] = bf2f(XQ[(size_t)t * 1024 + h * 256 + lane + 64 * r]) * 0.0625f;
        LDS_WAIT();
        float o[1][4] = {{0.f, 0.f, 0.f, 0.f}}, m[1] = {-1e30f}, l[1] = {0.f};
        const bf16* Kb = XKV + (size_t)b * 256 * 2048 + h * 256;
        wave_attn_blocks<256, 1>(qs, Kb, 2048, Kb + 1024, 2048, 0xFull, 1 << 29, 1 << 30, o, m, l, lane);
        const float inv = 1.0f / l[0];
#pragma unroll
        for (int r = 0; r < 4; ++r) XO[(size_t)t * 1024 + h * 256 + lane + 64 * r] = (bf16)f2bf(o[0][r] * inv);
    }
}

DI void phase_router(const Ctx& C, int layer, const float* x) {
    const int lane = C.lane, e = lane & 31, half = lane >> 5;
    unsigned char* tab = C.ws + WS_MOETAB + (size_t)layer * 2 * MiB;
    int* TOKE = (int*)(tab + MT_TOKE); float* TOKG = (float*)(tab + MT_TOKG); int* HIST = (int*)(tab + MT_HIST);
    const float* rw = INP(float, 23) + (size_t)layer * 1024 * 32; const float* rb = INP(float, 24) + layer * 32;
    LAS int* hist = (LAS int*)(C.lds);
    for (int chunk = C.bid; chunk < 256; chunk += C.G) {
        if (C.tid < 32) hist[C.tid] = 0;
        __syncthreads();
        for (int i = 0; i < 16; ++i) {
            const int t = chunk * 128 + C.wave * 16 + i;
            const float* xr = x + (size_t)t * DM + half * 512;
            float acc = 0.f;
            for (int k = 0; k < 512; k += 4) { const f32x4 xv = *(const f32x4*)(xr + k); const float* wp = rw + (size_t)(half * 512 + k) * 32 + e;
                acc += xv[0] * wp[0] + xv[1] * wp[32] + xv[2] * wp[64] + xv[3] * wp[96]; }
            acc += __shfl_xor(acc, 32);
            float val = acc + rb[e];
            float tv[4]; int ti[4];
#pragma unroll
            for (int r = 0; r < 4; ++r) {
                float best = val; int bi = e;
#pragma unroll
                for (int off = 16; off >= 1; off >>= 1) { const float ov = __shfl_xor(best, off); const int oi = __shfl_xor(bi, off); if (ov > best || (ov == best && oi < bi)) { best = ov; bi = oi; } }
                tv[r] = best; ti[r] = bi; if (e == bi) val = -3.0e38f;
            }
            const float e1 = __expf(tv[1] - tv[0]), e2 = __expf(tv[2] - tv[0]), e3 = __expf(tv[3] - tv[0]); const float inv = 1.0f / (1.0f + e1 + e2 + e3);
            if (lane == 0) {
                TOKE[t * 4 + 0] = ti[0]; TOKE[t * 4 + 1] = ti[1]; TOKE[t * 4 + 2] = ti[2]; TOKE[t * 4 + 3] = ti[3];
                TOKG[t * 4 + 0] = inv; TOKG[t * 4 + 1] = e1 * inv; TOKG[t * 4 + 2] = e2 * inv; TOKG[t * 4 + 3] = e3 * inv;
                atomicAdd((int*)(hist + ti[0]), 1); atomicAdd((int*)(hist + ti[1]), 1); atomicAdd((int*)(hist + ti[2]), 1); atomicAdd((int*)(hist + ti[3]), 1);
            }
        }
        __syncthreads();
        if (C.tid < 32) HIST[chunk * 32 + C.tid] = hist[C.tid];
        __syncthreads();
    }
}
DI void phase_moe_scatter(const Ctx& C, int layer) {
    const int lane = C.lane, tid = C.tid;
    unsigned char* tab = C.ws + WS_MOETAB + (size_t)layer * 2 * MiB;
    const int* TOKE = (const int*)(tab + MT_TOKE); int* TOKSLOT = (int*)(tab + MT_TOKSLOT); const int* HIST = (const int*)(tab + MT_HIST); int* TILEE = (int*)(tab + MT_TILEE);
    const bf16* XB = WSP(bf16, WS_XB); bf16* XG = WSP(bf16, R_XG);
    LAS int* tot = (LAS int*)(C.lds);
    LAS int* ebase = tot + 32;
    LAS int* cntl = tot + 96;
    LAS int* slots = tot + 128;
    if (tid < 32) { int s = 0; for (int c = 0; c < 256; ++c) s += HIST[c * 32 + tid]; tot[tid] = s; }
    __syncthreads();
    if (tid == 0) { int acc = 0; for (int e = 0; e < 32; ++e) { ebase[e] = acc; acc += (tot[e] + 255) & ~255; } ebase[32] = acc; }
    __syncthreads();
    if (C.bid == 0) { const int nmt = ebase[32] >> 8; for (int mt = tid; mt < nmt; mt += NTHREADS) { int e = 0; while (e < 31 && (mt << 8) >= ebase[e + 1]) ++e; TILEE[mt] = e; } if (tid == 0) TILEE[1023] = nmt; }
    for (int e = C.bid; e < 32; e += C.G) { const int r0 = ebase[e] + tot[e], r1 = ebase[e + 1];
        for (int r = r0 + C.wave; r < r1; r += NWAVES) { u32x4* p = (u32x4*)(XG + (size_t)r * 1024); p[lane] = (u32x4){0u, 0u, 0u, 0u}; p[lane + 64] = (u32x4){0u, 0u, 0u, 0u}; } }
    for (int chunk = C.bid; chunk < 256; chunk += C.G) {
        __syncthreads();
        if (tid < 32) { int s = ebase[tid]; for (int c = 0; c < chunk; ++c) s += HIST[c * 32 + tid]; cntl[tid] = s; }
        __syncthreads();
        if (C.wave == 0) {
            for (int bt = 0; bt < 8; ++bt) {
                const int idx = bt * 64 + lane; const int my_e = TOKE[(size_t)chunk * 512 + idx];
                int slot = 0;
                for (int e = 0; e < 32; ++e) { const u64 mm = __ballot(my_e == e); if (mm) { const int base = cntl[e]; if (my_e == e) slot = base + __popcll(mm & ((1ull << lane) - 1ull)); LDS_WAIT(); if (lane == 0) cntl[e] = base + __popcll(mm); LDS_WAIT(); } }
                slots[idx] = slot; TOKSLOT[(size_t)chunk * 512 + idx] = slot;
            }
        }
        __syncthreads();
        for (int i = C.wave; i < 512; i += NWAVES) { const int t = chunk * 128 + (i >> 2); const int slot = slots[i];
            const u32x4* src = (const u32x4*)(XB + (size_t)t * 1024); u32x4* dst = (u32x4*)(XG + (size_t)slot * 1024);
            dst[lane] = src[lane]; dst[lane + 64] = src[lane + 64]; }
    }
}
DI void phase_moe_combine_ln(const Ctx& C, int layer, const float* xprev, const float* gam, const float* bet, float* xnext, bf16* xb) {
    unsigned char* tab = C.ws + WS_MOETAB + (size_t)layer * 2 * MiB;
    const float* TOKG = (const float*)(tab + MT_TOKG); const int* TOKSLOT = (const int*)(tab + MT_TOKSLOT); const bf16* YEXP = WSP(bf16, R_YEXP);
    for (int t = C.gw; t < T; t += C.NGW) {
        f32x4 v[4];
#pragma unroll
        for (int j = 0; j < 4; ++j) v[j] = ((const f32x4*)(xprev + (size_t)t * DM))[C.lane + 64 * j] * ALPHA;
#pragma unroll
        for (int r = 0; r < 4; ++r) { const float gt = TOKG[t * 4 + r]; const int slot = TOKSLOT[t * 4 + r]; const u32x2* yr = (const u32x2*)(YEXP + (size_t)slot * 1024);
#pragma unroll
            for (int j = 0; j < 4; ++j) { const u32x2 w = yr[C.lane + 64 * j];
                v[j][0] += gt * __uint_as_float(w.x << 16); v[j][1] += gt * __uint_as_float(w.x & 0xffff0000u); v[j][2] += gt * __uint_as_float(w.y << 16); v[j][3] += gt * __uint_as_float(w.y & 0xffff0000u); } }
        ln_row_finish(v, gam, bet, xnext + (size_t)t * DM, xb + (size_t)t * DM, C.lane);
    }
}

constexpr size_t R_UT = WS_R1 + 224 * MiB, R_SST = WS_R1 + 352 * MiB, R_QT = WS_R1 + 416 * MiB, R_DEC = WS_R1 + 448 * MiB;
constexpr int HG_QS = 136, HG_TS = 72;
constexpr int HG_QT = 0, HG_KT = 17408, HG_KDT = 34816, HG_VT = 53248, HG_PM = 71680, HG_PART = 80896;
DI void phase_hgrn_conv(const Ctx& C) {
    const int lane = C.lane; const bf16* PROJ = WSP(bf16, R_PROJ); bf16* MIXIN = WSP(bf16, WS_MIXIN);
    const float* cw = INP(float, 15); const float* cb = INP(float, 16);
    for (int t = C.gw; t < T; t += C.NGW) {
        const int s = t % SEQ; const bf16* pr = PROJ + (size_t)t * ODD_IN;
#pragma unroll
        for (int j = 0; j < 8; ++j) {
            const int c = lane + 64 * j;
            const float z0 = bf2f(pr[3072 + c]) * bf2f(pr[2048 + c]);
            const float z1 = s >= 1 ? bf2f(pr[3072 + c - ODD_IN]) * bf2f(pr[2048 + c - ODD_IN]) : 0.f;
            const float z2 = s >= 2 ? bf2f(pr[3072 + c - 2 * ODD_IN]) * bf2f(pr[2048 + c - 2 * ODD_IN]) : 0.f;
            const float y = cw[c] * z2 + cw[512 + c] * z1 + cw[1024 + c] * z0 + cb[c];
            MIXIN[(size_t)t * 1024 + 512 + c] = (bf16)f2bf(bf2f(pr[2560 + c]) * y);
        }
    }
}
DI void phase_hgrn_h1(const Ctx& C) {
    const int tid = C.tid, lane = C.lane, r32 = lane & 31, h2 = lane >> 5, w = C.wave;
    const bf16* PROJ = WSP(bf16, R_PROJ); const float* lbl = INP(float, 13);
    float* ORAW = WSP(float, R_ORAW); float* UT = WSP(float, R_UT); bf16* QTg = WSP(bf16, R_QT); float* DEC = WSP(float, R_DEC);
    LAS bf16* Qt = (LAS bf16*)(C.lds + HG_QT); LAS bf16* Kt = (LAS bf16*)(C.lds + HG_KT); LAS bf16* KdT = (LAS bf16*)(C.lds + HG_KDT); LAS bf16* VT = (LAS bf16*)(C.lds + HG_VT);
    LAS bf16* Pm = (LAS bf16*)(C.lds + HG_PM); LAS float* part = (LAS float*)(C.lds + HG_PART);
    const int k = tid & 127, tq = tid >> 7;
    for (int unit = C.bid; unit < 2048; unit += C.G) {
        const int c = unit & 63, bh = unit >> 6, h = bh & 3, b = bh >> 2;
        const size_t t0 = (size_t)b * SEQ + 64 * c;
        const float l0 = lbl[h * 128 + k], l1 = lbl[512 + h * 128 + k]; const float lbk = 1.0f / (1.0f + __expf(l0 - l1));
        float bl[16], kk[16]; float run = 0.f;
#pragma unroll
        for (int i = 0; i < 16; ++i) {
            const float z = bf2f(PROJ[(t0 + 16 * tq + i) * ODD_IN + 512 + h * 128 + k]);
            const float sg = 1.0f / (1.0f + __expf(-z)); const float f = lbk + (1.0f - lbk) * sg;
            run += __logf(f); bl[i] = run; kk[i] = (1.0f - lbk) * (1.0f - sg);
        }
        part[tq * 128 + k] = run;
        __syncthreads();
        float off = 0.f, blast = 0.f;
#pragma unroll
        for (int q = 0; q < 4; ++q) { const float pv = part[q * 128 + k]; blast += pv; off += (q < tq) ? pv : 0.f; }
        unsigned kdp[8], vtp[8];
#pragma unroll
        for (int i = 0; i < 16; ++i) {
            const int t = 16 * tq + i; const float bb = bl[i] + off; const float eb = __expf(bb);
            const float qv = bf2f(PROJ[(t0 + t) * ODD_IN + h * 128 + k]);
            const unsigned qt = f2bf(qv * eb);
            Qt[t * HG_QS + k] = (bf16)qt; QTg[(t0 + t) * 512 + h * 128 + k] = (bf16)qt;
            Kt[t * HG_QS + k] = (bf16)f2bf(kk[i] * __expf(-bb));
            const unsigned kd = f2bf(kk[i] * __expf(blast - bb)); const unsigned vv = PROJ[(t0 + t) * ODD_IN + 1024 + h * 128 + k];
            if (i & 1) { kdp[i >> 1] |= kd << 16; vtp[i >> 1] |= vv << 16; } else { kdp[i >> 1] = kd; vtp[i >> 1] = vv; }
        }
        *(LAS u32x4*)(KdT + k * HG_TS + 16 * tq) = (u32x4){kdp[0], kdp[1], kdp[2], kdp[3]}; *(LAS u32x4*)(KdT + k * HG_TS + 16 * tq + 8) = (u32x4){kdp[4], kdp[5], kdp[6], kdp[7]};
        *(LAS u32x4*)(VT + k * HG_TS + 16 * tq) = (u32x4){vtp[0], vtp[1], vtp[2], vtp[3]}; *(LAS u32x4*)(VT + k * HG_TS + 16 * tq + 8) = (u32x4){vtp[4], vtp[5], vtp[6], vtp[7]};
        if (tq == 0) DEC[(size_t)unit * 128 + k] = __expf(blast);
        __syncthreads();
        if (w < 4) {
            const int si = w >> 1, ti = w & 1;
            if (si <= ti) {
                f32x16 acc;
#pragma unroll
                for (int i = 0; i < 16; ++i) acc[i] = 0.f;
#pragma unroll
                for (int ks = 0; ks < 8; ++ks) { const bf16x8 av = *(const LAS bf16x8*)(Kt + (32 * si + r32) * HG_QS + 16 * ks + 8 * h2), bv = *(const LAS bf16x8*)(Qt + (32 * ti + r32) * HG_QS + 16 * ks + 8 * h2);
                    acc = __builtin_amdgcn_mfma_f32_32x32x16_bf16(av, bv, acc, 0, 0, 0); }
                const int tt = 32 * ti + r32;
#pragma unroll
                for (int rg = 0; rg < 4; ++rg) { const int s0 = 32 * si + 8 * rg + 4 * h2; float v4[4];
#pragma unroll
                    for (int e = 0; e < 4; ++e) v4[e] = (s0 + e <= tt) ? acc[4 * rg + e] : 0.f;
                    *(LAS u32x2*)(Pm + tt * HG_TS + s0) = (u32x2){pk2(v4[0], v4[1]), pk2(v4[2], v4[3])}; }
            }
        }
        __syncthreads();
        {
            const int ti = w >> 2, vi = w & 3; const int nks = ti ? 4 : 2;
            f32x16 acc;
#pragma unroll
            for (int i = 0; i < 16; ++i) acc[i] = 0.f;
            for (int ks = 0; ks < nks; ++ks) { const bf16x8 av = *(const LAS bf16x8*)(Pm + (32 * ti + r32) * HG_TS + 16 * ks + 8 * h2), bv = *(const LAS bf16x8*)(VT + (32 * vi + r32) * HG_TS + 16 * ks + 8 * h2);
                acc = __builtin_amdgcn_mfma_f32_32x32x16_bf16(av, bv, acc, 0, 0, 0); }
#pragma unroll
            for (int rg = 0; rg < 16; ++rg) ORAW[(t0 + 32 * ti + crow16(rg, h2)) * 512 + h * 128 + 32 * vi + r32] = acc[rg];
        }
#pragma unroll
        for (int rep = 0; rep < 2; ++rep) {
            const int idx = w + 8 * rep, vi = idx >> 2, ki = idx & 3;
            f32x16 acc;
#pragma unroll
            for (int i = 0; i < 16; ++i) acc[i] = 0.f;
#pragma unroll
            for (int ks = 0; ks < 4; ++ks) { const bf16x8 av = *(const LAS bf16x8*)(VT + (32 * vi + r32) * HG_TS + 16 * ks + 8 * h2), bv = *(const LAS bf16x8*)(KdT + (32 * ki + r32) * HG_TS + 16 * ks + 8 * h2);
                acc = __builtin_amdgcn_mfma_f32_32x32x16_bf16(av, bv, acc, 0, 0, 0); }
#pragma unroll
            for (int rg = 0; rg < 16; ++rg) UT[(size_t)unit * 16384 + (32 * vi + crow16(rg, h2)) * 128 + 32 * ki + r32] = acc[rg];
        }
        __syncthreads();
    }
}
DI void phase_hgrn_h2(const Ctx& C) {
    const float* UT = WSP(float, R_UT); const float* DEC = WSP(float, R_DEC); bf16* SST = WSP(bf16, R_SST);
    for (int idx = C.bid * NTHREADS + C.tid; idx < 32 * 16384; idx += C.G * NTHREADS) {
        const int bh = idx >> 14, vk = idx & 16383, k = vk & 127;
        float S = 0.f;
#pragma unroll 4
        for (int c = 0; c < 64; ++c) { const size_t u = (size_t)bh * 64 + c; SST[u * 16384 + vk] = (bf16)f2bf(S); S = DEC[u * 128 + k] * S + UT[u * 16384 + vk]; }
    }
}
DI void phase_hgrn_h3(const Ctx& C) {
    const int lane = C.lane, r32 = lane & 31, h2 = lane >> 5, w = C.wave;
    const bf16* PROJ = WSP(bf16, R_PROJ); const float* ORAW = WSP(float, R_ORAW); const bf16* QTg = WSP(bf16, R_QT); const bf16* SST = WSP(bf16, R_SST); bf16* MIXIN = WSP(bf16, WS_MIXIN); const float* ng = INP(float, 14);
    LAS float* RS = (LAS float*)(C.lds);
    for (int unit = C.bid; unit < 2048; unit += C.G) {
        const int c = unit & 63, bh = unit >> 6, h = bh & 3, b = bh >> 2;
        const size_t t0 = (size_t)b * SEQ + 64 * c;
        const int ti = w >> 2, vi = w & 3;
        f32x16 acc;
#pragma unroll
        for (int i = 0; i < 16; ++i) acc[i] = 0.f;
#pragma unroll
        for (int ks = 0; ks < 8; ++ks) { const bf16x8 av = *(const bf16x8*)(QTg + (t0 + 32 * ti + r32) * 512 + h * 128 + 16 * ks + 8 * h2), bv = *(const bf16x8*)(SST + (size_t)unit * 16384 + (32 * vi + r32) * 128 + 16 * ks + 8 * h2);
            acc = __builtin_amdgcn_mfma_f32_32x32x16_bf16(av, bv, acc, 0, 0, 0); }
        float ss[16];
#pragma unroll
        for (int rg = 0; rg < 16; ++rg) { acc[rg] += ORAW[(t0 + 32 * ti + crow16(rg, h2)) * 512 + h * 128 + 32 * vi + r32]; float q = acc[rg] * acc[rg];
            q += __shfl_xor(q, 1); q += __shfl_xor(q, 2); q += __shfl_xor(q, 4); q += __shfl_xor(q, 8); q += __shfl_xor(q, 16); ss[rg] = q; }
        if (r32 == 0) {
#pragma unroll
            for (int rg = 0; rg < 16; ++rg) RS[(32 * ti + crow16(rg, h2)) * 4 + vi] = ss[rg];
        }
        __syncthreads();
        const float gsc = ng[h * 128 + 32 * vi + r32];
#pragma unroll
        for (int rg = 0; rg < 16; ++rg) { const int tt = 32 * ti + crow16(rg, h2); const f32x4 r4 = *(const LAS f32x4*)(RS + tt * 4);
            const float rstd = 1.0f / sqrtf(((r4[0] + r4[1]) + (r4[2] + r4[3])) * (1.0f / 128.0f) + 1e-6f);
            const float gg = bf2f(PROJ[(t0 + tt) * ODD_IN + 1536 + h * 128 + 32 * vi + r32]);
            MIXIN[(t0 + tt) * 1024 + h * 128 + 32 * vi + r32] = (bf16)f2bf(acc[rg] * rstd * gsc * (gg / (1.0f + __expf(-gg)))); }
        __syncthreads();
    }
}

DI void gemm_bf16out(const Ctx& C, const bf16* A, const bf16* Bt, int M, int N, bf16* O, int ldc, float scale = 1.0f) {
    pg8::DenseOrder S; S.init(A, 1024, Bt, 1024, M, N, C.G, C.bid);
    pg8::EpiBf16 E{O, ldc, nullptr, 0, scale};
    pg8::gemm_phase<pg8::EpiBf16, pg8::DenseOrder>(C.lds, 1024, 1024, 1024, S, E);
}
DI void gemm_f32out(const Ctx& C, const bf16* A, const bf16* Bt, int M, int N, float* O, int ldc) {
    pg8::DenseOrder S; S.init(A, 1024, Bt, 1024, M, N, C.G, C.bid);
    pg8::EpiF32 E{O, ldc};
    pg8::gemm_phase<pg8::EpiF32, pg8::DenseOrder>(C.lds, 1024, 1024, 1024, S, E);
}
DI void gemm_moe_gu(const Ctx& C, int layer) {
    unsigned char* tab = C.ws + WS_MOETAB + (size_t)layer * 2 * MiB; const int* TILEE = (const int*)(tab + MT_TILEE);
    const int nmt = (int)__hip_atomic_load((const unsigned*)TILEE + 1023, __ATOMIC_RELAXED, __HIP_MEMORY_SCOPE_AGENT);
    pg8::MoeOrder S; S.init(WSP(bf16, R_XG), WSP(bf16, WS_WGU) + (size_t)layer * 32 * 2048 * 1024, 2048, TILEE, nmt, C.G, C.bid);
    pg8::EpiSwiglu E{WSP(bf16, R_ACT), INP(float, 26) + (size_t)layer * 32 * 2048};
    pg8::gemm_phase<pg8::EpiSwiglu, pg8::MoeOrder>(C.lds, 1024, 1024, 1024, S, E);
}
DI void gemm_moe_dn(const Ctx& C, int layer) {
    unsigned char* tab = C.ws + WS_MOETAB + (size_t)layer * 2 * MiB; const int* TILEE = (const int*)(tab + MT_TILEE);
    const int nmt = (int)__hip_atomic_load((const unsigned*)TILEE + 1023, __ATOMIC_RELAXED, __HIP_MEMORY_SCOPE_AGENT);
    pg8::MoeOrder S; S.init(WSP(bf16, R_ACT), WSP(bf16, WS_WDN) + (size_t)layer * 32 * 1024 * 1024, 1024, TILEE, nmt, C.G, C.bid);
    pg8::EpiBf16 E{WSP(bf16, R_YEXP), 1024, INP(float, 28) + (size_t)layer * 32 * 1024, 1024, 1.0f};
    pg8::gemm_phase<pg8::EpiBf16, pg8::MoeOrder>(C.lds, 1024, 1024, 1024, S, E);
}


DI void gemm_cmp_h1(const Ctx& C) {
    pg8::CmpH1Order S{C.G, C.bid, (const char*)WSP(bf16, R_KCMP), (const char*)WSP(bf16, R_VCMP), (const char*)WSP(bf16, WS_W1T)};
    pg8::EpiCmpH1 E{WSP(bf16, R_H1), WSP(float, WS_BP)};
    pg8::gemm_phase<pg8::EpiCmpH1, pg8::CmpH1Order>(C.lds, 1024, 2048, 2048, S, E);
}
DI void gemm_cmp_h2(const Ctx& C) {
    pg8::CmpH2Order S{C.G, C.bid, (const char*)WSP(bf16, R_H1), (const char*)WSP(bf16, WS_W2T)};
    pg8::EpiCmpOut E{WSP(bf16, R_KC), WSP(bf16, R_VC)};
    pg8::gemm_phase<pg8::EpiCmpOut, pg8::CmpH2Order>(C.lds, 256, 256, 256, S, E);
}

constexpr size_t R_PATT = WS_R1;
DI void gemm_xattn_s(const Ctx& C, int layer) {
    pg8::XattnSOrder S{C.G, C.bid, (const char*)WSP(bf16, WS_XQ), (const char*)(WSP(bf16, WS_XKV) + (size_t)layer * 2048 * 1024)};
    pg8::EpiSoftmax E{WSP(bf16, R_PATT), (LAS float*)(C.lds + LDSCTL_OFF + 1024)};
    pg8::gemm_phase<pg8::EpiSoftmax, pg8::XattnSOrder>(C.lds, 1024, 1024, 256, S, E);
}
DI void gemm_xattn_o(const Ctx& C, int layer) {
    pg8::XattnOOrder S{C.G, C.bid, (const char*)WSP(bf16, R_PATT), (const char*)(WSP(bf16, WS_XKV) + (size_t)(2 + layer) * 2048 * 1024)};
    pg8::EpiBf16 E{WSP(bf16, WS_XO), 1024, nullptr, 0, 1.0f};
    pg8::gemm_phase<pg8::EpiBf16, pg8::XattnOOrder>(C.lds, 256, 2048, 256, S, E);
}

enum { PH_CONV, PH_PROJ0, PH_PREP0, PH_CMPH, PH_CMPO, PH_CMPATT, PH_SLCWIN, PH_OUT0, PH_LN0,
       PH_XQ0, PH_XS0, PH_XO0, PH_XW0, PH_XLN0, PH_RT0, PH_SC0, PH_GU0, PH_DN0, PH_CB0,
       PH_PROJ1, PH_HPREP, PH_HSCAN, PH_HNORM, PH_OUT1, PH_LN1,
       PH_XQ1, PH_XS1, PH_XO1, PH_XW1, PH_XLN1, PH_RT1, PH_SC1, PH_GU1, PH_DN1, PH_CB1, N_PHASES };
#ifndef PHMASK
#define PHMASK 0xffffffffffffffffull
#endif
__global__ void __launch_bounds__(NTHREADS, 2) mega(Args args) {
    extern __shared__ __attribute__((aligned(16))) unsigned char lds_raw[];
    Ctx C;
    C.lds = (LAS unsigned char*)lds_raw; C.ws = args.ws; C.a = &args;
    C.tid = threadIdx.x; C.lane = C.tid & 63; C.wave = __builtin_amdgcn_readfirstlane(C.tid >> 6); C.bid = blockIdx.x; C.G = gridDim.x;
    C.gw = C.bid * NWAVES + C.wave; C.NGW = C.G * NWAVES;
    volatile LAS unsigned* MISC = (volatile LAS unsigned*)(C.lds + LDSCTL_OFF);
    for (int u = C.tid; u < 256; u += NTHREADS) MISC[u] = 0u;
    __syncthreads();
    const int lo = args.ph_lo, hi = args.ph_hi;
    XcdBarrier bar; bar.bar = (unsigned*)(C.ws + WS_CTL) + CW_BAR; bar.x = 0; bar.st = nullptr;
    if (hi - lo > 1) bar = xcd_barrier_post((unsigned*)(C.ws + WS_CTL) + CW_BAR, MISC + 8);
#define IN(k) ((((PHMASK) >> (k)) & 1ull) && lo <= (k) && (k) < hi)
#define SEAM(k) do { if (IN(k) && (k) + 1 < hi) xcd_barrier(bar); } while (0)
    const float* lng = INP(float, 21); const float* lnb = INP(float, 22);
    float* XA = WSP(float, WS_XA); float* XBF = WSP(float, WS_XBF); bf16* XB = WSP(bf16, WS_XB);
    const bf16* MEMB = WSP(bf16, WS_MEMB);

    if (IN(PH_CONV)) { phase_convert(C); } SEAM(PH_CONV);
    if (IN(PH_PROJ0)) {
        gemm_bf16out(C, XB, WSP(bf16, WS_WEVEN), T, EVEN_PAD, WSP(bf16, R_PROJ), EVEN_PAD);
#pragma unroll
        for (int l = 0; l < 2; ++l) {
            const bf16* wkv = WSP(bf16, WS_WXKV) + (size_t)l * 2048 * 1024;
            gemm_bf16out(C, MEMB, wkv, 2048, 1024, WSP(bf16, WS_XKV) + (size_t)l * 2048 * 1024, 1024);
            gemm_bf16out(C, wkv + (size_t)1024 * 1024, MEMB, 1024, 2048, WSP(bf16, WS_XKV) + (size_t)(2 + l) * 2048 * 1024, 2048);
        }
    } SEAM(PH_PROJ0);
    if (IN(PH_PREP0)) { phase_nsa_prep(C); } SEAM(PH_PREP0);
    if (IN(PH_CMPH)) { gemm_cmp_h1(C); } SEAM(PH_CMPH);
    if (IN(PH_CMPO)) { gemm_cmp_h2(C); } SEAM(PH_CMPO);
    if (IN(PH_CMPATT)) { phase_nsa(C); } SEAM(PH_CMPATT);
    if (IN(PH_SLCWIN)) { phase_sgu(C); } SEAM(PH_SLCWIN);
    if (IN(PH_OUT0)) { gemm_f32out(C, WSP(bf16, WS_MIXIN), WSP(bf16, WS_WOUTE), T, 1024, WSP(float, WS_YBUF), 1024); } SEAM(PH_OUT0);
    if (IN(PH_LN0)) { phase_ln(C, INP(float, 0), WSP(float, WS_YBUF), lng + 0 * 1024, lnb + 0 * 1024, XA, XB); } SEAM(PH_LN0);
    if (IN(PH_XQ0)) { gemm_bf16out(C, XB, WSP(bf16, WS_WXQ), T, 1024, WSP(bf16, WS_XQ), 1024, 0.0625f); } SEAM(PH_XQ0);
    if (IN(PH_XS0)) { gemm_xattn_s(C, 0); } SEAM(PH_XS0);
    if (IN(PH_XO0)) { gemm_xattn_o(C, 0); } SEAM(PH_XO0);
    if (IN(PH_XW0)) { gemm_f32out(C, WSP(bf16, WS_XO), WSP(bf16, WS_WXO), T, 1024, WSP(float, WS_YBUF), 1024); } SEAM(PH_XW0);
    if (IN(PH_XLN0)) { phase_ln(C, XA, WSP(float, WS_YBUF), lng + 1 * 1024, lnb + 1 * 1024, XBF, XB); } SEAM(PH_XLN0);
    if (IN(PH_RT0)) { phase_router(C, 0, XBF); } SEAM(PH_RT0);
    if (IN(PH_SC0)) { phase_moe_scatter(C, 0); } SEAM(PH_SC0);
    if (IN(PH_GU0)) { gemm_moe_gu(C, 0); } SEAM(PH_GU0);
    if (IN(PH_DN0)) { gemm_moe_dn(C, 0); } SEAM(PH_DN0);
    if (IN(PH_CB0)) { phase_moe_combine_ln(C, 0, XBF, lng + 2 * 1024, lnb + 2 * 1024, XA, XB); } SEAM(PH_CB0);
    if (IN(PH_PROJ1)) { gemm_bf16out(C, XB, WSP(bf16, WS_WODD), T, ODD_IN, WSP(bf16, R_PROJ), ODD_IN); } SEAM(PH_PROJ1);
    if (IN(PH_HPREP)) { phase_hgrn_h1(C); phase_hgrn_conv(C); } SEAM(PH_HPREP);
    if (IN(PH_HSCAN)) { phase_hgrn_h2(C); } SEAM(PH_HSCAN);
    if (IN(PH_HNORM)) { phase_hgrn_h3(C); } SEAM(PH_HNORM);
    if (IN(PH_OUT1)) { gemm_f32out(C, WSP(bf16, WS_MIXIN), WSP(bf16, WS_WOUTO), T, 1024, WSP(float, WS_YBUF), 1024); } SEAM(PH_OUT1);
    if (IN(PH_LN1)) { phase_ln(C, XA, WSP(float, WS_YBUF), lng + 3 * 1024, lnb + 3 * 1024, XBF, XB); } SEAM(PH_LN1);
    if (IN(PH_XQ1)) { gemm_bf16out(C, XB, WSP(bf16, WS_WXQ) + (size_t)1024 * 1024, T, 1024, WSP(bf16, WS_XQ), 1024, 0.0625f); } SEAM(PH_XQ1);
    if (IN(PH_XS1)) { gemm_xattn_s(C, 1); } SEAM(PH_XS1);
    if (IN(PH_XO1)) { gemm_xattn_o(C, 1); } SEAM(PH_XO1);
    if (IN(PH_XW1)) { gemm_f32out(C, WSP(bf16, WS_XO), WSP(bf16, WS_WXO) + (size_t)1024 * 1024, T, 1024, WSP(float, WS_YBUF), 1024); } SEAM(PH_XW1);
    if (IN(PH_XLN1)) { phase_ln(C, XBF, WSP(float, WS_YBUF), lng + 4 * 1024, lnb + 4 * 1024, XA, XB); } SEAM(PH_XLN1);
    if (IN(PH_RT1)) { phase_router(C, 1, XA); } SEAM(PH_RT1);
    if (IN(PH_SC1)) { phase_moe_scatter(C, 1); } SEAM(PH_SC1);
    if (IN(PH_GU1)) { gemm_moe_gu(C, 1); } SEAM(PH_GU1);
    if (IN(PH_DN1)) { gemm_moe_dn(C, 1); } SEAM(PH_DN1);
    if (IN(PH_CB1)) { phase_moe_combine_ln(C, 1, XA, lng + 5 * 1024, lnb + 5 * 1024, args.out, XB); }
}

extern "C" void kernel_launch(void* const* d_in, const int* in_sizes, int n_in, void* d_out, int out_size, void* d_ws, size_t ws_size, hipStream_t stream) {
    static int grid = 0;
    if (grid == 0) {
        if (n_in != 29 || ws_size < WS_END) { fprintf(stderr, "kernel_launch: unexpected n_in %d / ws_size %zu (need %zu)\n", n_in, ws_size, (size_t)WS_END); grid = -1; return; }
        int dev = 0, cus = 0, per_cu = 0;
        hipGetDevice(&dev); hipDeviceGetAttribute(&cus, hipDeviceAttributeMultiprocessorCount, dev);
        if (hipFuncSetAttribute((const void*)mega, hipFuncAttributeMaxDynamicSharedMemorySize, LDS_BYTES) != hipSuccess) { fprintf(stderr, "kernel_launch: hipFuncSetAttribute failed\n"); grid = -1; return; }
        hipOccupancyMaxActiveBlocksPerMultiprocessor(&per_cu, (const void*)mega, NTHREADS, LDS_BYTES);
        if (per_cu < 1) fprintf(stderr, "kernel_launch: occupancy query says %d\n", per_cu);
        grid = cus > 0 ? cus : 256;
    }
    if (grid < 0) return;
    hipMemsetAsync((char*)d_ws + WS_CTL, 0, CTL_BYTES, stream);
    Args a{};
    for (int i = 0; i < 29; ++i) a.in[i] = d_in[i];
    a.out = (float*)d_out; a.ws = (unsigned char*)d_ws;
#if ONE_LAUNCH
    a.ph_lo = 0; a.ph_hi = N_PHASES;
    hipLaunchKernelGGL(mega, dim3(grid), dim3(NTHREADS), LDS_BYTES, stream, a);
#else
    for (int p = 0; p < N_PHASES; ++p) { a.ph_lo = p; a.ph_hi = p + 1; hipLaunchKernelGGL(mega, dim3(grid), dim3(NTHREADS), LDS_BYTES, stream, a); }
#endif
}
```

```cpp
#include <hip/hip_runtime.h>
#include <cstdio>
#include <cstdint>

#ifndef ONE_LAUNCH
#define ONE_LAUNCH 1
#endif

#define LAS __attribute__((address_space(3)))
#define DI __device__ __forceinline__
typedef unsigned short bf16;
typedef short bf16x8 __attribute__((ext_vector_type(8)));
typedef float f32x4 __attribute__((ext_vector_type(4)));
typedef float f32x2 __attribute__((ext_vector_type(2)));
typedef unsigned u32x4 __attribute__((ext_vector_type(4)));
typedef unsigned u32x2 __attribute__((ext_vector_type(2)));
typedef unsigned long long u64;
typedef int i32x4 __attribute__((ext_vector_type(4)));

constexpr int NB = 8, SEQ = 4096, T = NB * SEQ, DM = 1024;
constexpr int EVEN_IN = 2328, EVEN_PAD = 2560, ODD_IN = 3584;
constexpr int NEXP = 32, TOPK = 4;
constexpr int XG_ROWS = T * TOPK + NEXP * 256;
constexpr float ALPHA = 1.41421356237f;
constexpr int NWAVES = 8, NTHREADS = 512;

constexpr size_t MiB = 1u << 20;
constexpr size_t WS_CTL = 0, CTL_BYTES = 1 * MiB;
constexpr size_t WS_WEVEN = 1 * MiB, WS_WODD = 6 * MiB, WS_WOUTE = 13 * MiB, WS_WOUTO = 15 * MiB, WS_WXQ = 17 * MiB, WS_WXKV = 21 * MiB, WS_WXO = 29 * MiB;
constexpr size_t WS_WGU = 33 * MiB, WS_WDN = 289 * MiB;
constexpr size_t WS_XB = 417 * MiB, WS_MEMB = 481 * MiB, WS_ROPEC = 485 * MiB, WS_ROPES = 489 * MiB;
constexpr size_t WS_MIXIN = 493 * MiB, WS_YBUF = 557 * MiB, WS_XA = 685 * MiB, WS_XBF = 813 * MiB;
constexpr size_t WS_XKV = 941 * MiB, WS_XQ = 957 * MiB, WS_XO = 1021 * MiB, WS_MOETAB = 1085 * MiB, WS_R1 = 1089 * MiB, WS_SMALL = 1905 * MiB, WS_END = 1909 * MiB;
constexpr size_t WS_W1T = WS_SMALL, WS_W2T = WS_SMALL + 2 * MiB, WS_SGW = WS_SMALL + 2 * MiB + 256 * 1024, WS_BP = WS_SMALL + 2 * MiB + 384 * 1024;
constexpr size_t R_PROJ = WS_R1, R_QN = WS_R1 + 224 * MiB, R_QR = WS_R1 + 256 * MiB, R_KCMP = WS_R1 + 288 * MiB, R_VCMP = WS_R1 + 297 * MiB;
constexpr size_t R_KSLC = WS_R1 + 306 * MiB, R_VSLC = WS_R1 + 314 * MiB, R_KWIN = WS_R1 + 322 * MiB, R_VWIN = WS_R1 + 330 * MiB;
constexpr size_t R_GATES = WS_R1 + 338 * MiB, R_UG = WS_R1 + 341 * MiB, R_VN = WS_R1 + 373 * MiB, R_H1 = WS_R1 + 405 * MiB;
constexpr size_t R_KC = WS_R1 + 413 * MiB, R_VC = WS_R1 + 414 * MiB, R_SELM = WS_R1 + 415 * MiB, R_OCMP = WS_R1 + 416 * MiB;
constexpr size_t R_FBUF = WS_R1 + 480 * MiB, R_ORAW = WS_R1 + 544 * MiB;
constexpr size_t R_XG = WS_R1, R_ACT = WS_R1 + 272 * MiB, R_YEXP = WS_R1 + 544 * MiB;
constexpr size_t MT_TOKE = 0, MT_TOKG = 512 * 1024, MT_TOKSLOT = 1024 * 1024, MT_HIST = 1536 * 1024, MT_TILEE = 1536 * 1024 + 64 * 1024;
constexpr int CW_BAR = 4096;

constexpr int STAGE_BYTES_LDS = 131072, LDSCTL_OFF = 131072, LDS_BYTES = 147456;

DI float bf2f(bf16 v) { return __uint_as_float(((unsigned)v) << 16); }
DI unsigned f2bf(float f) { unsigned u = __float_as_uint(f); return (u + 0x7fffu + ((u >> 16) & 1u)) >> 16; }
DI unsigned pk2(float lo, float hi) { return f2bf(lo) | (f2bf(hi) << 16); }
DI float wave_sum(float v) {
#pragma unroll
    for (int o = 1; o < 64; o <<= 1) v += __shfl_xor(v, o);
    return v;
}
DI float wave_max(float v) {
#pragma unroll
    for (int o = 1; o < 64; o <<= 1) v = fmaxf(v, __shfl_xor(v, o));
    return v;
}
DI float rdlane(float x, int i) { return __builtin_bit_cast(float, __builtin_amdgcn_readlane(__builtin_bit_cast(int, x), i)); }
DI float gelu_tanh(float x) { const float u = 0.7978845608028654f * (x + 0.044715f * x * x * x); return 0.5f * x * (1.0f + tanhf(u)); }
DI float sigmoidf(float x) { return 1.0f / (1.0f + __expf(-x)); }
#define LDS_WAIT() asm volatile("s_waitcnt lgkmcnt(0)" ::: "memory")

#define XB_TMO      128
#define XB_XCNT(j)  (256  + 64 * (j))
#define XB_XSUB(j)  (1280 + 64 * (j))
#define XB_XGEN(j)  (2304 + 64 * (j))
#define XB_TOP      3328
#define XB_TOPGEN   3392
#define XCD_BAR_WORDS 3456
#define XB_SPIN_CAP (1u << 18)
__device__ __forceinline__ unsigned xb_ld(unsigned* p)              { return __hip_atomic_load(p, __ATOMIC_RELAXED, __HIP_MEMORY_SCOPE_AGENT); }
__device__ __forceinline__ unsigned xb_add(unsigned* p, unsigned v) { return __hip_atomic_fetch_add(p, v, __ATOMIC_RELAXED, __HIP_MEMORY_SCOPE_AGENT); }
__device__ __forceinline__ unsigned xb_xcc_id() { return (unsigned)__builtin_amdgcn_s_getreg((3 << 11) | 20) & 0xFu; }
#define XB_SPIN(cond, bar) do { unsigned _sp = 0; while (cond) { __builtin_amdgcn_s_sleep(1); \
    if ((++_sp & 255u) == 0u) { if (xb_ld(&(bar)[XB_TMO])) break; if (_sp > XB_SPIN_CAP) { atomicAdd(&(bar)[XB_TMO], 1u); break; } } } } while (0)
struct XcdBarrier { unsigned* bar; unsigned x; volatile LAS unsigned* st; };
__device__ __forceinline__ XcdBarrier xcd_barrier_post(unsigned* bar, volatile LAS unsigned* st) {
    XcdBarrier b; b.bar = bar; b.x = xb_xcc_id(); b.st = st;
    if (threadIdx.x == 0) (void)xb_add(&bar[XB_XCNT(b.x)], 1u);
    return b;
}
__device__ __forceinline__ void xcd_barrier_complete(unsigned* bar, unsigned x, unsigned& nloc, unsigned& nx) {
    const unsigned G = gridDim.x * gridDim.y * gridDim.z;
    unsigned sum, cnt, mine, sp = 0u;
    for (;;) {
        sum = 0u; cnt = 0u; mine = 0u;
#pragma unroll
        for (unsigned j = 0; j < 16; ++j) { const unsigned c = xb_ld(&bar[XB_XCNT(j)]); sum += c; cnt += (c > 0u) ? 1u : 0u; mine = (j == x) ? c : mine; }
        if (sum == G) break;
        __builtin_amdgcn_s_sleep(1);
        if ((++sp & 255u) == 0u) { if (xb_ld(&bar[XB_TMO])) break; if (sp > XB_SPIN_CAP) { atomicAdd(&bar[XB_TMO], 1u); break; } }
    }
    nloc = mine > 0u ? mine : 1u; nx = cnt > 0u ? cnt : 1u;
}
__device__ __forceinline__ void xcd_barrier(const XcdBarrier& b) {
    asm volatile("s_waitcnt vmcnt(0)" ::: "memory");
    __syncthreads();
    if (threadIdx.x == 0) {
        unsigned* bar = b.bar;
        __builtin_amdgcn_s_waitcnt(0);
        unsigned nloc = b.st[0], nx = b.st[1];
        if (nloc == 0u) { xcd_barrier_complete(bar, b.x, nloc, nx); b.st[0] = nloc; b.st[1] = nx; }
        const unsigned old = xb_add(&bar[XB_XSUB(b.x)], 1u);
        const unsigned gen = old / nloc;
        if (old + 1u == (gen + 1u) * nloc) {
            __builtin_amdgcn_fence(__ATOMIC_RELEASE, "agent");
            asm volatile("s_waitcnt vmcnt(0)" ::: "memory");
            const unsigned og = xb_add(&bar[XB_TOP], 1u);
            const unsigned tg = og / nx;
            if (og + 1u == (tg + 1u) * nx) xb_add(&bar[XB_TOPGEN], 1u);
            else XB_SPIN(xb_ld(&bar[XB_TOPGEN]) == tg, bar);
            __builtin_amdgcn_fence(__ATOMIC_ACQUIRE, "agent");
            xb_add(&bar[XB_XGEN(b.x)], 1u);
            asm volatile("s_waitcnt vmcnt(0)" ::: "memory");
        } else {
            XB_SPIN(xb_ld(&bar[XB_XGEN(b.x)]) == gen, bar);
            __builtin_amdgcn_fence(__ATOMIC_ACQUIRE, "agent");
            asm volatile("s_waitcnt vmcnt(0)" ::: "memory");
        }
    }
    __syncthreads();
}

namespace pg8 {
constexpr int BM = 256, BK = 64, HALF = 128, HTB = HALF * BK * 2, STAGE_BYTES = 8 * HTB, NXCD = 8, WGM = 8;
DI int lds_byte(int r, int c) { const int st = (r >> 4) * 2 + (c >> 5), rr = r & 15, cc = c & 31, ob = rr * 64 + cc * 2; return st * 1024 + (ob ^ (((ob >> 9) & 1) << 5)); }
DI void stage_rc(int b, int& R, int& C) { const int st = b / 1024, sb = b % 1024, swz = sb ^ (((sb >> 9) & 1) << 5); R = (st >> 1) * 16 + swz / 64; C = (st & 1) * 32 + (swz % 64) / 2; }
DI int perm32(int rho) { const int n = rho >> 4, i = rho & 15; return 8 * (i >> 2) + 4 * n + (i & 3); }

struct Unit { int pm, pn, e; const char* A; const char* B; };

struct DenseOrder {
    int nM, nN, nwg, G, c; const char* A; const char* Bt; size_t tstepA, tstepB;
    DI void init(const bf16* A_, int lda, const bf16* Bt_, int ldb, int M, int N, int G_, int c_) { nM = M / BM; nN = N / BM; nwg = nM * nN; G = G_; c = c_; A = (const char*)A_; Bt = (const char*)Bt_; tstepA = (size_t)BM * lda * 2; tstepB = (size_t)BM * ldb * 2; }
    DI bool next(int i, Unit& u) const {
        const long L = (long)i * G + c; if (L >= nwg) return false;
        int wgid = (int)L; { const int q = nwg / NXCD, r = nwg % NXCD, xcd = wgid % NXCD, off = wgid / NXCD; wgid = (xcd < r ? xcd * (q + 1) : r * (q + 1) + (xcd - r) * q) + off; }
        const int nig = WGM * nN, gid = wgid / nig, fm = gid * WGM, gsz = (nM - fm) < WGM ? (nM - fm) : WGM;
        u.pm = fm + ((wgid % nig) % gsz); u.pn = (wgid % nig) / gsz; u.e = 0;
        u.A = A + (size_t)u.pm * tstepA; u.B = Bt + (size_t)u.pn * tstepB; return true;
    }
};
struct MoeOrder {
    int nN, nunits, G, c; const char* A; const char* W; size_t estride; const int* tile_e;
    DI void init(const bf16* A_, const bf16* W_, int Nexp, const int* tile_e_, int nmt, int G_, int c_) { nN = Nexp / BM; nunits = nmt * nN; G = G_; c = c_; A = (const char*)A_; W = (const char*)W_; estride = (size_t)Nexp * 1024 * 2; tile_e = tile_e_; }
    DI bool next(int i, Unit& u) const {
        int pm, pn;
        if ((G & 7) == 0) { const int x = c & 7, slot = c >> 3, v = i * (G >> 3) + slot, q = v / nN; pn = v % nN; pm = 8 * q + x; if (pm * nN >= nunits) return false; }
        else { const long L = (long)i * G + c; if (L >= nunits) return false; pm = (int)L / nN; pn = (int)L % nN; }
        u.pm = pm; u.pn = pn;
        u.e = (int)__hip_atomic_load((const unsigned*)tile_e + u.pm, __ATOMIC_RELAXED, __HIP_MEMORY_SCOPE_AGENT) & 31;
        u.A = A + (size_t)u.pm * (BM * 1024 * 2); u.B = W + (size_t)u.e * estride + (size_t)u.pn * (BM * 1024 * 2); return true;
    }
};

DI unsigned cvt_pk_bf16(float lo, float hi) { unsigned r; asm volatile("v_cvt_pk_bf16_f32 %0, %1, %2" : "=v"(r) : "v"(lo), "v"(hi)); return r; }

struct EpiF32 {
    static constexpr bool PERM = false;
    float* C; int ldc;
    DI void operator()(f32x4 (&acc)[2][2][4][2], const Unit& u, int wr, int wc, int fr, int fq) const {
        const int row0 = u.pm * BM + wr * 64 + fr, col0 = u.pn * BM + wc * 32 + 4 * fq;
#pragma unroll
        for (int ai = 0; ai < 2; ++ai)
#pragma unroll
            for (int m = 0; m < 4; ++m) { float* rowp = C + (size_t)(row0 + ai * HALF + m * 16) * ldc + col0;
#pragma unroll
                for (int bj = 0; bj < 2; ++bj)
#pragma unroll
                    for (int n = 0; n < 2; ++n) *(f32x4*)(rowp + bj * HALF + n * 16) = acc[ai][bj][m][n]; }
    }
};
struct EpiBf16 {
    static constexpr bool PERM = true;
    bf16* O; int ldc; const float* bias; int bias_estride; float scale;
    DI void operator()(f32x4 (&acc)[2][2][4][2], const Unit& u, int wr, int wc, int fr, int fq) const {
        const int row0 = u.pm * BM + wr * 64 + fr, col0 = u.pn * BM + wc * 32 + 8 * fq;
        f32x4 bv[2][2];
#pragma unroll
        for (int bj = 0; bj < 2; ++bj)
#pragma unroll
            for (int n = 0; n < 2; ++n) bv[bj][n] = bias ? *(const f32x4*)(bias + (size_t)u.e * bias_estride + col0 + bj * HALF + 4 * n) : (f32x4){0.f, 0.f, 0.f, 0.f};
#pragma unroll
        for (int ai = 0; ai < 2; ++ai)
#pragma unroll
            for (int m = 0; m < 4; ++m) { bf16* rowp = O + (size_t)(row0 + ai * HALF + m * 16) * ldc + col0;
#pragma unroll
                for (int bj = 0; bj < 2; ++bj) { const f32x4 v0 = acc[ai][bj][m][0] * scale + bv[bj][0], v1 = acc[ai][bj][m][1] * scale + bv[bj][1];
                    u32x4 w; w.x = cvt_pk_bf16(v0[0], v0[1]); w.y = cvt_pk_bf16(v0[2], v0[3]); w.z = cvt_pk_bf16(v1[0], v1[1]); w.w = cvt_pk_bf16(v1[2], v1[3]);
                    *(u32x4*)(rowp + bj * HALF) = w; } }
    }
};
struct EpiSwiglu {
    static constexpr bool PERM = true;
    bf16* O; const float* bias;
    DI void operator()(f32x4 (&acc)[2][2][4][2], const Unit& u, int wr, int wc, int fr, int fq) const {
        const int row0 = u.pm * BM + wr * 64 + fr, cw = u.pn * HALF + wc * 32 + 8 * fq;
        const float* bb = bias + (size_t)u.e * 2048 + cw;
        f32x4 bg[2], bu[2];
#pragma unroll
        for (int n = 0; n < 2; ++n) { bg[n] = *(const f32x4*)(bb + 4 * n); bu[n] = *(const f32x4*)(bb + 1024 + 4 * n); }
#pragma unroll
        for (int ai = 0; ai < 2; ++ai)
#pragma unroll
            for (int m = 0; m < 4; ++m) {
                float r[8];
#pragma unroll
                for (int n = 0; n < 2; ++n)
#pragma unroll
                    for (int j = 0; j < 4; ++j) {
                        const float g = fminf(acc[ai][0][m][n][j] + bg[n][j], 7.0f);
                        const float up = fminf(fmaxf(acc[ai][1][m][n][j] + bu[n][j], -7.0f), 7.0f);
                        r[n * 4 + j] = (up + 1.0f) * (g / (1.0f + __expf(-1.702f * g)));
                    }
                u32x4 w; w.x = cvt_pk_bf16(r[0], r[1]); w.y = cvt_pk_bf16(r[2], r[3]); w.z = cvt_pk_bf16(r[4], r[5]); w.w = cvt_pk_bf16(r[6], r[7]);
                *(u32x4*)(O + (size_t)(row0 + ai * HALF + m * 16) * 1024 + cw) = w;
            }
    }
};


struct EpiSoftmax {
    static constexpr bool PERM = true;
    bf16* P; LAS float* X;
    DI void operator()(f32x4 (&acc)[2][2][4][2], const Unit& u, int wr, int wc, int fr, int fq) const {
        float mw[2][4];
#pragma unroll
        for (int ai = 0; ai < 2; ++ai)
#pragma unroll
            for (int m = 0; m < 4; ++m) {
                float mx = -3.0e38f;
#pragma unroll
                for (int bj = 0; bj < 2; ++bj)
#pragma unroll
                    for (int n = 0; n < 2; ++n)
#pragma unroll
                        for (int j = 0; j < 4; ++j) mx = fmaxf(mx, acc[ai][bj][m][n][j]);
                mx = fmaxf(mx, __shfl_xor(mx, 16)); mx = fmaxf(mx, __shfl_xor(mx, 32));
                float sm = 0.f;
#pragma unroll
                for (int bj = 0; bj < 2; ++bj)
#pragma unroll
                    for (int n = 0; n < 2; ++n)
#pragma unroll
                        for (int j = 0; j < 4; ++j) { const float e = __expf(acc[ai][bj][m][n][j] - mx); acc[ai][bj][m][n][j] = e; sm += e; }
                sm += __shfl_xor(sm, 16); sm += __shfl_xor(sm, 32);
                mw[ai][m] = mx;
                if (fq == 0) { LAS f32x2* xp = (LAS f32x2*)X + (ai * HALF + wr * 64 + m * 16 + fr) * 4 + wc; *xp = (f32x2){mx, sm}; }
                __builtin_amdgcn_sched_barrier(0);
            }
        asm volatile("s_waitcnt lgkmcnt(0)" ::: "memory"); __builtin_amdgcn_s_barrier(); asm volatile("" ::: "memory");
#pragma unroll
        for (int ai = 0; ai < 2; ++ai)
#pragma unroll
            for (int m = 0; m < 4; ++m) {
                const int row = ai * HALF + wr * 64 + m * 16 + fr;
                const f32x4 a = *(const LAS f32x4*)(X + row * 8), b = *(const LAS f32x4*)(X + row * 8 + 4);
                const float M = fmaxf(fmaxf(a[0], a[2]), fmaxf(b[0], b[2]));
                const float L = a[1] * __expf(a[0] - M) + a[3] * __expf(a[2] - M) + b[1] * __expf(b[0] - M) + b[3] * __expf(b[2] - M);
                const float f = __expf(mw[ai][m] - M) / L;
                bf16* rowp = P + ((size_t)u.pm * BM + row) * 256 + wc * 32 + 8 * fq;
#pragma unroll
                for (int bj = 0; bj < 2; ++bj) { const f32x4 v0 = acc[ai][bj][m][0] * f, v1 = acc[ai][bj][m][1] * f;
                    u32x4 w; w.x = cvt_pk_bf16(v0[0], v0[1]); w.y = cvt_pk_bf16(v0[2], v0[3]); w.z = cvt_pk_bf16(v1[0], v1[1]); w.w = cvt_pk_bf16(v1[2], v1[3]);
                    *(u32x4*)(rowp + bj * HALF) = w; }
                __builtin_amdgcn_sched_barrier(0);
            }
    }
};

struct EpiCmpH1 {
    static constexpr bool PERM = true;
    bf16* H; const float* bp;
    DI void operator()(f32x4 (&acc)[2][2][4][2], const Unit& u, int wr, int wc, int fr, int fq) const {
        const int row0 = u.pm * BM + wr * 64 + fr, col0 = wc * 32 + 8 * fq;
#pragma unroll
        for (int ai = 0; ai < 2; ++ai)
#pragma unroll
            for (int m = 0; m < 4; ++m) { bf16* rowp = H + (size_t)(row0 + ai * HALF + m * 16) * 256 + col0;
#pragma unroll
                for (int bj = 0; bj < 2; ++bj) { float r[8];
#pragma unroll
                    for (int n = 0; n < 2; ++n)
#pragma unroll
                        for (int j = 0; j < 4; ++j) { const float x = acc[ai][bj][m][n][j] + bp[u.e * 256 + col0 + bj * HALF + 4 * n + j]; const float t = 0.7978845608028654f * (x + 0.044715f * x * x * x);
                            const float e2 = __expf(2.0f * t); r[n * 4 + j] = 0.5f * x * (1.0f + (1.0f - 2.0f / (e2 + 1.0f))); }
                    u32x4 w; w.x = cvt_pk_bf16(r[0], r[1]); w.y = cvt_pk_bf16(r[2], r[3]); w.z = cvt_pk_bf16(r[4], r[5]); w.w = cvt_pk_bf16(r[6], r[7]);
                    *(u32x4*)(rowp + bj * HALF) = w; } }
    }
};
struct CmpH1Order { int G, c; const char* KC; const char* VC; const char* W1T;
    DI bool next(int i, Unit& u) const { const int L = i * G + c; if (L >= 32) return false; const int kv = L >> 4, bg = L & 15; u.pm = L; u.pn = 0; u.e = kv;
        u.A = (kv ? VC : KC) + (size_t)bg * 4096 * 64 * 2; u.B = W1T + (size_t)kv * 256 * 2048 * 2; return true; } };
struct EpiCmpOut {
    static constexpr bool PERM = true;
    bf16* KC; bf16* VCT;
    DI void operator()(f32x4 (&acc)[2][2][4][2], const Unit& u, int wr, int wc, int fr, int fq) const {
        if (wc >= 2) return;
        const int bg = u.pm & 15, d0 = wc * 32 + 8 * fq;
#pragma unroll
        for (int ai = 0; ai < 2; ++ai)
#pragma unroll
            for (int m = 0; m < 4; ++m) { const int cidx = ai * HALF + wr * 64 + m * 16 + fr; const bool pad = (cidx == 255);
                float r[8];
#pragma unroll
                for (int n = 0; n < 2; ++n)
#pragma unroll
                    for (int j = 0; j < 4; ++j) r[n * 4 + j] = pad ? 0.f : acc[ai][0][m][n][j];
                if (u.e == 0) { u32x4 w; w.x = cvt_pk_bf16(r[0], r[1]); w.y = cvt_pk_bf16(r[2], r[3]); w.z = cvt_pk_bf16(r[4], r[5]); w.w = cvt_pk_bf16(r[6], r[7]);
                    *(u32x4*)(KC + ((size_t)bg * 256 + cidx) * 64 + d0) = w; }
                else {
#pragma unroll
                    for (int e = 0; e < 8; ++e) VCT[((size_t)bg * 64 + d0 + e) * 256 + cidx] = (bf16)(cvt_pk_bf16(r[e], 0.f) & 0xffffu); }
            }
    }
};
struct CmpH2Order { int G, c; const char* H; const char* W2T;
    DI bool next(int i, Unit& u) const { const int L = i * G + c; if (L >= 32) return false; const int kv = L >> 4; u.pm = L; u.pn = 0; u.e = kv;
        u.A = H + (size_t)L * 256 * 256 * 2; u.B = W2T + (size_t)kv * 256 * 256 * 2; return true; } };

struct XkvOrder { int G, c; const char* MEM; const char* WKV; char* OUT;
    DI bool next(int i, Unit& u) const {
        const int L = i * G + c; if (L >= 128) return false;
        const int l = L >> 6, r = L & 63; const char* wkv = WKV + (size_t)l * 2048 * 1024 * 2;
        if (r < 32) { u.pm = r >> 2; u.pn = r & 3; u.e = l; u.A = MEM + (size_t)u.pm * 256 * 1024 * 2; u.B = wkv + (size_t)u.pn * 256 * 1024 * 2; }
        else { const int q = r - 32; u.pm = q >> 3; u.pn = q & 7; u.e = 2 + l; u.A = wkv + (size_t)(1024 + u.pm * 256) * 1024 * 2; u.B = MEM + (size_t)u.pn * 256 * 1024 * 2; }
        return true;
    }
};
struct EpiXkv {
    static constexpr bool PERM = true;
    bf16* O;
    DI void operator()(f32x4 (&acc)[2][2][4][2], const Unit& u, int wr, int wc, int fr, int fq) const {
        const int ldc = u.e < 2 ? 1024 : 2048; bf16* base = O + (size_t)u.e * 2048 * 1024;
        const int row0 = u.pm * BM + wr * 64 + fr, col0 = u.pn * BM + wc * 32 + 8 * fq;
#pragma unroll
        for (int ai = 0; ai < 2; ++ai)
#pragma unroll
            for (int m = 0; m < 4; ++m) { bf16* rowp = base + (size_t)(row0 + ai * HALF + m * 16) * ldc + col0;
#pragma unroll
                for (int bj = 0; bj < 2; ++bj) { const f32x4 v0 = acc[ai][bj][m][0], v1 = acc[ai][bj][m][1];
                    u32x4 w; w.x = cvt_pk_bf16(v0[0], v0[1]); w.y = cvt_pk_bf16(v0[2], v0[3]); w.z = cvt_pk_bf16(v1[0], v1[1]); w.w = cvt_pk_bf16(v1[2], v1[3]);
                    *(u32x4*)(rowp + bj * HALF) = w; } }
    }
};
struct XattnSOrder {
    int G, c; const char* XQ; const char* XK;
    DI bool next(int i, Unit& u) const {
        const int L = i * G + c; if (L >= 512) return false;
        const int qt = L & 15, h = (L >> 4) & 3, b = L >> 6;
        u.pm = L; u.pn = 0; u.e = 0;
        u.A = XQ + ((size_t)(b * 4096 + qt * 256) * 1024 + h * 256) * 2; u.B = XK + ((size_t)(b * 256) * 1024 + h * 256) * 2; return true;
    }
};
struct XattnOOrder {
    int G, c; const char* P; const char* VT;
    DI bool next(int i, Unit& u) const {
        const int L = i * G + c; if (L >= 512) return false;
        const int qt = L & 15, h = (L >> 4) & 3, b = L >> 6;
        u.pm = b * 16 + qt; u.pn = h; u.e = 0;
        u.A = P + (size_t)L * 256 * 256 * 2; u.B = VT + ((size_t)(h * 256) * 2048 + b * 256) * 2; return true;
    }
};

template <class Epi, class Sched>
DI void gemm_phase(LAS unsigned char* lds, const int lda, const int ldb, const int K, const Sched& S, const Epi& E) {
    const int tid = threadIdx.x, wid = __builtin_amdgcn_readfirstlane(tid >> 6), lane = tid & 63, wr = wid >> 2, wc = wid & 3, fr = lane & 15, fq = lane >> 4;
    const int nt = K / BK;
    unsigned voffA[2], voffB[2];
#pragma unroll
    for (int i = 0; i < 2; ++i) { int R, C; stage_rc(tid * 16 + i * 8192, R, C); const int Rb = Epi::PERM ? ((R & ~31) + perm32(R & 31)) : R;
        voffA[i] = (unsigned)(R * lda + C) * 2u; voffB[i] = (unsigned)(Rb * ldb + C) * 2u; }
    const size_t kstep = (size_t)(BK * 2);
    const size_t hstepA = (size_t)HALF * lda * 2, hstepB = (size_t)HALF * ldb * 2;
    const unsigned ldsw = (unsigned)wid * 1024u;
    const int aoff = lds_byte(wr * 64 + fr, fq * 8), boff = lds_byte(wc * 32 + fr, fq * 8);
#define PG8_SA(b, h) (((b) * 2 + (h)) * HTB)
#define PG8_SB(b, h) ((4 + (b) * 2 + (h)) * HTB)
#define PG8_STAGE(bufoff, gbase, voff) do { _Pragma("unroll") for (int _i = 0; _i < 2; ++_i) \
        __builtin_amdgcn_global_load_lds((const unsigned*)((const char*)(gbase) + (voff)[_i]), (LAS unsigned*)(lds + (bufoff) + ldsw + _i * 8192), 16, 0, 0); } while (0)
#define PG8_LDA(dst, b, h) do { _Pragma("unroll") for (int m = 0; m < 4; ++m) _Pragma("unroll") for (int k = 0; k < 2; ++k) dst[m][k] = *(const LAS bf16x8*)(lds + PG8_SA(b, h) + aoff + m * 2048 + k * 1024); } while (0)
#define PG8_LDB(dst, b, h) do { _Pragma("unroll") for (int n = 0; n < 2; ++n) _Pragma("unroll") for (int k = 0; k < 2; ++k) dst[n][k] = *(const LAS bf16x8*)(lds + PG8_SB(b, h) + boff + n * 2048 + k * 1024); } while (0)
#define PG8_MMA(ai, bj, At, Bt) do { __builtin_amdgcn_s_setprio(1); _Pragma("unroll") for (int m = 0; m < 4; ++m) _Pragma("unroll") for (int n = 0; n < 2; ++n) _Pragma("unroll") for (int k = 0; k < 2; ++k) \
        acc[ai][bj][m][n] = __builtin_amdgcn_mfma_f32_16x16x32_bf16(Bt[n][k], At[m][k], acc[ai][bj][m][n], 0, 0, 0); __builtin_amdgcn_s_setprio(0); } while (0)
#define PG8_WAIT_V(n) asm volatile("s_waitcnt vmcnt(" #n ")" ::: "memory")
#define PG8_WAIT_L(n) asm volatile("s_waitcnt lgkmcnt(" #n ")" ::: "memory")
#define PG8_BAR __builtin_amdgcn_s_barrier()
#define PG8_SCHED __builtin_amdgcn_sched_barrier(0)
    Unit cur, nxt; int ui = 0;
    if (!S.next(0, cur)) return;
    f32x4 acc[2][2][4][2];
#pragma unroll
    for (int a = 0; a < 2; ++a)
#pragma unroll
        for (int b = 0; b < 2; ++b)
#pragma unroll
            for (int m = 0; m < 4; ++m)
#pragma unroll
                for (int n = 0; n < 2; ++n) acc[a][b][m][n] = (f32x4){0.f, 0.f, 0.f, 0.f};
    bf16x8 At[4][2], B0[2][2], B1[2][2];
    const char* cA = cur.A; const char* cB = cur.B;
    PG8_STAGE(PG8_SB(0, 0), cB, voffB); PG8_STAGE(PG8_SA(0, 0), cA, voffA); PG8_STAGE(PG8_SB(0, 1), cB + hstepB, voffB); PG8_STAGE(PG8_SA(0, 1), cA + hstepA, voffA);
    if (wr == 1) PG8_BAR;
    PG8_WAIT_V(4); PG8_BAR;
    PG8_STAGE(PG8_SB(1, 0), cB + kstep, voffB); PG8_STAGE(PG8_SA(1, 0), cA + kstep, voffA); PG8_STAGE(PG8_SB(1, 1), cB + hstepB + kstep, voffB);
    PG8_WAIT_V(6); PG8_BAR;
    for (;;) {
        const bool has_next = S.next(ui + 1, nxt);
        const char* nA = has_next ? nxt.A : cA; const char* nB = has_next ? nxt.B : cB;
#pragma nounroll
        for (int t = 0; t < nt; t += 2) {
            const bool last = (t == nt - 2);
            const char* a1 = cA + (size_t)(t + 1) * kstep;
            const char* a2 = last ? nA : cA + (size_t)(t + 2) * kstep; const char* b2 = last ? nB : cB + (size_t)(t + 2) * kstep;
            const char* a3 = a2 + kstep; const char* b3 = b2 + kstep;
            PG8_LDB(B0, 0, 0); PG8_SCHED; PG8_LDA(At, 0, 0); PG8_STAGE(PG8_SA(1, 1), a1 + hstepA, voffA);
            PG8_WAIT_L(8); PG8_BAR; PG8_WAIT_L(0); PG8_MMA(0, 0, At, B0); PG8_BAR; PG8_SCHED;
            PG8_LDB(B1, 0, 1); PG8_STAGE(PG8_SB(0, 0), b2, voffB);
            PG8_BAR; PG8_WAIT_L(0); PG8_MMA(0, 1, At, B1); PG8_BAR;
            PG8_LDA(At, 0, 1); PG8_STAGE(PG8_SA(0, 0), a2, voffA);
            PG8_BAR; PG8_WAIT_L(0); PG8_MMA(1, 0, At, B0); PG8_BAR; PG8_SCHED;
            PG8_STAGE(PG8_SB(0, 1), b2 + hstepB, voffB);
            PG8_WAIT_V(6); PG8_BAR; PG8_MMA(1, 1, At, B1); PG8_BAR;
            PG8_LDB(B0, 1, 0); PG8_SCHED; PG8_LDA(At, 1, 0); PG8_STAGE(PG8_SA(0, 1), a2 + hstepA, voffA);
            PG8_WAIT_L(8); PG8_BAR; PG8_WAIT_L(0); PG8_MMA(0, 0, At, B0); PG8_BAR; PG8_SCHED;
            PG8_LDB(B1, 1, 1); PG8_STAGE(PG8_SB(1, 0), b3, voffB);
            PG8_BAR; PG8_WAIT_L(0); PG8_MMA(0, 1, At, B1); PG8_BAR;
            PG8_LDA(At, 1, 1); PG8_STAGE(PG8_SA(1, 0), a3, voffA);
            PG8_BAR; PG8_WAIT_L(0); PG8_MMA(1, 0, At, B0); PG8_BAR; PG8_SCHED;
            PG8_STAGE(PG8_SB(1, 1), b3 + hstepB, voffB);
            PG8_WAIT_V(6); PG8_BAR; PG8_MMA(1, 1, At, B1); PG8_BAR;
        }
        E(acc, cur, wr, wc, fr, fq);
        if (!has_next) break;
#pragma unroll
        for (int a = 0; a < 2; ++a)
#pragma unroll
            for (int b = 0; b < 2; ++b)
#pragma unroll
                for (int m = 0; m < 4; ++m)
#pragma unroll
                    for (int n = 0; n < 2; ++n) acc[a][b][m][n] = (f32x4){0.f, 0.f, 0.f, 0.f};
        cur = nxt; cA = nA; cB = nB; ++ui;
    }
    PG8_WAIT_V(0);
    if (wr == 0) PG8_BAR;
    PG8_BAR;
#undef PG8_SA
#undef PG8_SB
#undef PG8_STAGE
#undef PG8_LDA
#undef PG8_LDB
#undef PG8_MMA
#undef PG8_WAIT_V
#undef PG8_WAIT_L
#undef PG8_BAR
#undef PG8_SCHED
}
}

struct Args { const void* in[29]; float* out; unsigned char* ws; int ph_lo, ph_hi; };

struct Ctx {
    LAS unsigned char* lds; unsigned char* ws; const Args* a;
    int tid, lane, wave, bid, G, gw, NGW;
};
#define WSP(type, off) ((type*)(C.ws + (off)))
#define INP(type, i) ((const type*)(C.a->in[i]))

DI void transpose_tile64(const float* W, int K, int ldw, int k0, int src0, int nvalid, bf16* WT, int drow0, LAS bf16* scr, int lane) {
    const int c4 = lane & 15, kr = lane >> 4; const bool ok = 4 * c4 < nvalid;
    f32x4 v[16];
#pragma unroll
    for (int i = 0; i < 16; ++i) v[i] = ok ? *(const f32x4*)(W + (size_t)(k0 + 4 * i + kr) * ldw + src0 + 4 * c4) : (f32x4){0.f, 0.f, 0.f, 0.f};
#pragma unroll
    for (int i = 0; i < 16; ++i) { LAS unsigned* p = (LAS unsigned*)(scr + (4 * i + kr) * 66 + 4 * c4); p[0] = pk2(v[i][0], v[i][1]); p[1] = pk2(v[i][2], v[i][3]); }
    LDS_WAIT();
    const int c8 = lane & 7;
#pragma unroll
    for (int j = 0; j < 8; ++j) { const int nn = (lane >> 3) + 8 * j; const LAS bf16* sp = scr + (8 * c8) * 66 + nn;
        u32x4 o; o.x = (unsigned)sp[0] | ((unsigned)sp[66] << 16); o.y = (unsigned)sp[132] | ((unsigned)sp[198] << 16); o.z = (unsigned)sp[264] | ((unsigned)sp[330] << 16); o.w = (unsigned)sp[396] | ((unsigned)sp[462] << 16);
        *(u32x4*)(WT + (size_t)(drow0 + nn) * K + k0 + 8 * c8) = o; }
    LDS_WAIT();
}
DI void transpose_plain(const float* W, int K, int N, bf16* WT, LAS bf16* scr, int item, int lane) {
    const int nt = N / 64, kb = item / nt, nb = item % nt;
    transpose_tile64(W, K, N, 64 * kb, 64 * nb, 64, WT, 64 * nb, scr, lane);
}
DI void transpose_even(const float* W, bf16* WT, LAS bf16* scr, int item, int lane) {
    const int kb = item / 40, dt = item % 40, r0 = 64 * dt; int src0, nv = 64;
    if (r0 < 896) src0 = r0;
    else if (r0 < 1024) src0 = 1024 + (r0 - 896);
    else if (r0 < 1536) src0 = 1304 + (r0 - 1024);
    else if (r0 < 2048) src0 = 1816 + (r0 - 1536);
    else if (r0 < 2176) src0 = 896 + (r0 - 2048);
    else if (r0 < 2304) src0 = 1152 + (r0 - 2176);
    else if (r0 < 2368) { src0 = 1280; nv = 24; }
    else { src0 = 0; nv = 0; }
    transpose_tile64(W, 1024, EVEN_IN, 64 * kb, src0, nv, WT, r0, scr, lane);
}
DI void transpose_gu(const float* W, bf16* WT, LAS bf16* scr, int item, int lane) {
    const int kb = item / 32, dt = item % 32, r0 = 64 * dt, pn = r0 >> 8, wi = r0 & 255;
    const int src0 = wi < 128 ? (pn * 128 + wi) : (1024 + pn * 128 + wi - 128);
    transpose_tile64(W, 1024, 2048, 64 * kb, src0, 64, WT, r0, scr, lane);
}

DI void phase_convert(const Ctx& C) {
    LAS bf16* scr = (LAS bf16*)(C.lds + C.wave * 16384);
    constexpr int I_EVEN = 16 * 40, I_ODD = 16 * (ODD_IN / 64), I_SQ = 16 * 16, I_KV = 16 * 32, I_GU = 16 * 32, I_DN = 16 * 16, I_W1 = 32 * 4, I_W2 = 4 * 4;
    constexpr int NITEMS = I_EVEN + I_ODD + 2 * I_SQ + 2 * I_SQ + 2 * I_KV + 2 * I_SQ + 64 * I_GU + 64 * I_DN + 2 * I_W1 + 2 * I_W2;
    for (int it = C.gw; it < NITEMS; it += C.NGW) {
        int r = it;
        if (r < 64 * I_GU) { const int le = r / I_GU; transpose_gu(INP(float, 25) + (size_t)le * 1024 * 2048, WSP(bf16, WS_WGU) + (size_t)le * 2048 * 1024, scr, r % I_GU, C.lane); continue; } r -= 64 * I_GU;
        if (r < 64 * I_DN) { const int le = r / I_DN; transpose_plain(INP(float, 27) + (size_t)le * 1024 * 1024, 1024, 1024, WSP(bf16, WS_WDN) + (size_t)le * 1024 * 1024, scr, r % I_DN, C.lane); continue; } r -= 64 * I_DN;
        if (r < I_EVEN) { transpose_even(INP(float, 3), WSP(bf16, WS_WEVEN), scr, r, C.lane); continue; } r -= I_EVEN;
        if (r < I_ODD) { transpose_plain(INP(float, 12), 1024, ODD_IN, WSP(bf16, WS_WODD), scr, r, C.lane); continue; } r -= I_ODD;
        if (r < I_SQ) { transpose_plain(INP(float, 11), 1024, 1024, WSP(bf16, WS_WOUTE), scr, r, C.lane); continue; } r -= I_SQ;
        if (r < I_SQ) { transpose_plain(INP(float, 17), 1024, 1024, WSP(bf16, WS_WOUTO), scr, r, C.lane); continue; } r -= I_SQ;
        if (r < 2 * I_SQ) { const int l = r / I_SQ; transpose_plain(INP(float, 18) + (size_t)l * 1024 * 1024, 1024, 1024, WSP(bf16, WS_WXQ) + (size_t)l * 1024 * 1024, scr, r % I_SQ, C.lane); continue; } r -= 2 * I_SQ;
        if (r < 2 * I_KV) { const int l = r / I_KV; transpose_plain(INP(float, 19) + (size_t)l * 1024 * 2048, 1024, 2048, WSP(bf16, WS_WXKV) + (size_t)l * 2048 * 1024, scr, r % I_KV, C.lane); continue; } r -= 2 * I_KV;
        if (r < 2 * I_SQ) { const int l = r / I_SQ; transpose_plain(INP(float, 20) + (size_t)l * 1024 * 1024, 1024, 1024, WSP(bf16, WS_WXO) + (size_t)l * 1024 * 1024, scr, r % I_SQ, C.lane); continue; } r -= 2 * I_SQ;
        if (r < 2 * I_W1) { const int kv = r / I_W1; transpose_plain(INP(float, 5) + (size_t)kv * 2048 * 256, 2048, 256, WSP(bf16, WS_W1T) + (size_t)kv * 256 * 2048, scr, r % I_W1, C.lane); continue; } r -= 2 * I_W1;
        { const int kv = r / I_W2, q = r % I_W2, kb = q >> 2, dt = q & 3;
          transpose_tile64(INP(float, 6) + (size_t)kv * 256 * 64, 256, 64, 64 * kb, 0, dt == 0 ? 64 : 0, WSP(bf16, WS_W2T) + (size_t)kv * 256 * 256, 64 * dt, scr, C.lane); }
    }
    for (int it = C.gw; it < 512; it += C.NGW) { const int kv = it >> 8, j = it & 255; const float* pos = INP(float, 4) + kv * 2048; const float* w1 = INP(float, 5) + (size_t)kv * 2048 * 256 + j;
        float acc = 0.f; for (int k = C.lane; k < 2048; k += 64) acc += pos[k] * w1[(size_t)k * 256]; acc = wave_sum(acc); if (C.lane == 0) WSP(float, WS_BP)[it] = acc; }
    { const float* sw = INP(float, 9); bf16* o = WSP(bf16, WS_SGW);
      for (int i = C.bid * NTHREADS + C.tid; i < 4 * 128 * 128; i += C.G * NTHREADS) { const int s2 = i & 127, tt = (i >> 7) & 127; o[i] = (bf16)(s2 <= tt ? f2bf(sw[i]) : 0u); } }
    const size_t gt = (size_t)C.bid * NTHREADS + C.tid, ngt = (size_t)C.G * NTHREADS;
    { const f32x4* x4 = INP(f32x4, 0); u32x2* o = WSP(u32x2, WS_XB);
      for (size_t i = gt; i < (size_t)T * DM / 4; i += ngt) { const f32x4 v = x4[i]; u32x2 w; w.x = pk2(v[0], v[1]); w.y = pk2(v[2], v[3]); o[i] = w; } }
    { const f32x4* x4 = INP(f32x4, 1); u32x2* o = WSP(u32x2, WS_MEMB);
      for (size_t i = gt; i < (size_t)NB * 256 * DM / 4; i += ngt) { const f32x4 v = x4[i]; u32x2 w; w.x = pk2(v[0], v[1]); w.y = pk2(v[2], v[3]); o[i] = w; } }
    { const int* pos = INP(int, 2); float* rc = WSP(float, WS_ROPEC); float* rs = WSP(float, WS_ROPES);
      for (size_t i = gt; i < (size_t)T * 32; i += ngt) { const int t = (int)(i >> 5), d = (int)(i & 31);
          const double inv = exp2(-(double)d * (13.287712379549449 / 32.0));
          const double ang = (double)pos[t] * inv;
          rc[i] = (float)cos(ang); rs[i] = (float)sin(ang); } }
}

DI void unpack8(const u32x4& w, float (&f)[8]) {
    f[0] = __uint_as_float(w.x << 16); f[1] = __uint_as_float(w.x & 0xffff0000u); f[2] = __uint_as_float(w.y << 16); f[3] = __uint_as_float(w.y & 0xffff0000u);
    f[4] = __uint_as_float(w.z << 16); f[5] = __uint_as_float(w.z & 0xffff0000u); f[6] = __uint_as_float(w.w << 16); f[7] = __uint_as_float(w.w & 0xffff0000u);
}
DI u32x4 pack8(const float (&f)[8]) { u32x4 w; w.x = pk2(f[0], f[1]); w.y = pk2(f[2], f[3]); w.z = pk2(f[4], f[5]); w.w = pk2(f[6], f[7]); return w; }
DI void rope8(float (&f)[8], const float (&cs)[8], const float (&sn)[8], int lane) {
#pragma unroll
    for (int e = 0; e < 8; ++e) { const float pv = __shfl_xor(f[e], 4); f[e] = (lane & 4) ? (f[e] * cs[e] + pv * sn[e]) : (f[e] * cs[e] - pv * sn[e]); }
}
DI void phase_nsa_prep(const Ctx& C) {
    const bf16* PROJ = WSP(bf16, R_PROJ); const float* RC = WSP(float, WS_ROPEC); const float* RS = WSP(float, WS_ROPES);
    bf16* QN = WSP(bf16, R_QN); bf16* QR = WSP(bf16, R_QR);
    float* GATES = WSP(float, R_GATES); bf16* UG = WSP(bf16, R_UG); bf16* VN = WSP(bf16, R_VN);
    const float* lng = INP(float, 7); const float* lnb = INP(float, 8);
    const int lane = C.lane;
    for (int t = C.gw; t < T; t += C.NGW) {
        const bf16* pr = PROJ + (size_t)t * EVEN_PAD;
        const int b = t / SEQ, s = t % SEQ;
        u32x4 L[5];
#pragma unroll
        for (int j = 0; j < 5; ++j) L[j] = *(const u32x4*)(pr + 512 * j + 8 * lane);
        float cs[8], sn[8];
        { const f32x4 c0 = *(const f32x4*)(RC + (size_t)t * 32 + 8 * (lane & 3)), c1 = *(const f32x4*)(RC + (size_t)t * 32 + 8 * (lane & 3) + 4);
          const f32x4 s0 = *(const f32x4*)(RS + (size_t)t * 32 + 8 * (lane & 3)), s1 = *(const f32x4*)(RS + (size_t)t * 32 + 8 * (lane & 3) + 4);
#pragma unroll
          for (int e = 0; e < 4; ++e) { cs[e] = c0[e]; cs[4 + e] = c1[e]; sn[e] = s0[e]; sn[4 + e] = s1[e]; } }
        float f[8];
        unpack8(L[0], f);
#pragma unroll
        for (int e = 0; e < 8; ++e) f[e] *= 0.125f;
        *(u32x4*)(QN + (size_t)t * 512 + 8 * lane) = pack8(f);
        rope8(f, cs, sn, lane);
        *(u32x4*)(QR + (size_t)t * 512 + 8 * lane) = pack8(f);
        { const int reg = lane >> 4, g = (lane >> 3) & 1; const size_t off = ((size_t)(b * 2 + g) * SEQ + s) * 64 + 8 * (lane & 7);
          unpack8(L[1], f); float fr[8];
#pragma unroll
          for (int e = 0; e < 8; ++e) fr[e] = f[e];
          rope8(fr, cs, sn, lane);
          bf16* dst = reg == 0 ? WSP(bf16, R_KCMP) : reg == 1 ? WSP(bf16, R_VCMP) : reg == 2 ? WSP(bf16, R_KSLC) : WSP(bf16, R_KWIN);
          *(u32x4*)(dst + off) = reg >= 2 ? pack8(fr) : L[1];
          if (lane < 32) { bf16* dv = lane < 16 ? WSP(bf16, R_VSLC) : WSP(bf16, R_VWIN); *(u32x4*)(dv + off) = L[4]; }
          else if (lane < 35) { unpack8(L[4], f); f32x4 g0, g1;
#pragma unroll
              for (int e = 0; e < 4; ++e) { g0[e] = sigmoidf(f[e]); g1[e] = sigmoidf(f[4 + e]); }
              *(f32x4*)(GATES + (size_t)t * 24 + 8 * (lane - 32)) = g0; *(f32x4*)(GATES + (size_t)t * 24 + 8 * (lane - 32) + 4) = g1; } }
        unpack8(L[2], f);
#pragma unroll
        for (int e = 0; e < 8; ++e) f[e] = gelu_tanh(f[e]);
        *(u32x4*)(UG + (size_t)t * 512 + 8 * lane) = pack8(f);
        unpack8(L[3], f); float sm = 0.f;
#pragma unroll
        for (int e = 0; e < 8; ++e) { f[e] = gelu_tanh(f[e]); sm += f[e]; }
        sm += __shfl_xor(sm, 1); sm += __shfl_xor(sm, 2); sm += __shfl_xor(sm, 4); sm += __shfl_xor(sm, 8);
        const float mean = sm * (1.0f / 128.0f); float sq = 0.f;
#pragma unroll
        for (int e = 0; e < 8; ++e) { f[e] -= mean; sq += f[e] * f[e]; }
        sq += __shfl_xor(sq, 1); sq += __shfl_xor(sq, 2); sq += __shfl_xor(sq, 4); sq += __shfl_xor(sq, 8);
        const float rstd = 1.0f / sqrtf(sq * (1.0f / 128.0f) + 1e-5f);
        { const f32x4 ga = *(const f32x4*)(lng + 8 * lane), gb = *(const f32x4*)(lng + 8 * lane + 4), ba = *(const f32x4*)(lnb + 8 * lane), bb = *(const f32x4*)(lnb + 8 * lane + 4);
#pragma unroll
          for (int e = 0; e < 4; ++e) { f[e] = f[e] * rstd * ga[e] + ba[e]; f[4 + e] = f[4 + e] * rstd * gb[e] + bb[e]; } }
        *(u32x4*)(VN + (size_t)t * 512 + 8 * lane) = pack8(f);
    }
}

template <int D, int NH>
DI void wave_attn_blocks(const LAS float* qs, const bf16* Kb, size_t kstride, const bf16* Vb, size_t vstride, u64 blkmask, int spos, int window,
                         float (&o)[NH][D / 64], float (&m)[NH], float (&l)[NH], int lane) {
    while (blkmask) {
        const int j = __builtin_ctzll(blkmask); blkmask &= blkmask - 1;
        const int key = 64 * j + lane; const bool valid = (key <= spos) && (spos - key < window);
        const bf16* kr = Kb + (size_t)key * kstride;
        float sc[NH];
#pragma unroll
        for (int h = 0; h < NH; ++h) sc[h] = 0.f;
#pragma unroll 2
        for (int d0 = 0; d0 < D; d0 += 8) {
            const bf16x8 kk = *(const bf16x8*)(kr + d0);
#pragma unroll
            for (int h = 0; h < NH; ++h) { const f32x4 q0 = *(const LAS f32x4*)(qs + h * D + d0), q1 = *(const LAS f32x4*)(qs + h * D + d0 + 4);
#pragma unroll
                for (int e = 0; e < 8; ++e) sc[h] += (e < 4 ? q0[e] : q1[e - 4]) * bf2f((bf16)kk[e]); }
        }
        float p[NH];
#pragma unroll
        for (int h = 0; h < NH; ++h) {
            const float sv = valid ? sc[h] : -1e30f; const float bm = wave_max(sv); const float mn = fmaxf(m[h], bm);
            const float corr = __expf(m[h] - mn); p[h] = valid ? __expf(sc[h] - mn) : 0.f;
            l[h] = l[h] * corr + wave_sum(p[h]); m[h] = mn;
#pragma unroll
            for (int r = 0; r < D / 64; ++r) o[h][r] *= corr;
        }
#pragma unroll 4
        for (int i = 0; i < 64; ++i) {
            const bf16* vr = Vb + (size_t)(64 * j + i) * vstride + lane;
            float vv[D / 64];
#pragma unroll
            for (int r = 0; r < D / 64; ++r) vv[r] = bf2f(vr[64 * r]);
#pragma unroll
            for (int h = 0; h < NH; ++h) { const float pi = rdlane(p[h], i);
#pragma unroll
                for (int r = 0; r < D / 64; ++r) o[h][r] += pi * vv[r]; }
        }
    }
}

constexpr int NSA_KS = 72, NSA_VS = 68;
constexpr int NSA_K0 = 0, NSA_K1 = 9216, NSA_V0 = 18432, NSA_V1 = 27136, NSA_IMP = 36864, NSA_TMASK = 53248, NSA_WUN = 53760;
typedef float f32x16 __attribute__((ext_vector_type(16)));
DI int crow16(int reg, int h2) { return (reg & 3) + 8 * (reg >> 2) + 4 * h2; }
template <int VMODE> DI void nsa_ld(u32x4& kr, u32x4& vr, const bf16* Kg, const bf16* Vg, size_t ldv, int tid) {
    const int row = tid >> 3, ch = tid & 7;
    kr = *(const u32x4*)(Kg + row * 64 + ch * 8);
    if (VMODE == 1) vr = *(const u32x4*)(Vg + (size_t)row * ldv + ch * 8);
    if (VMODE == 2) vr = *(const u32x4*)(Vg + row * 64 + ch * 8);
}
template <int VMODE> DI void nsa_st(LAS bf16* Kb, LAS bf16* Vb, const u32x4& kr, const u32x4& vr, int tid) {
    const int row = tid >> 3, ch = tid & 7;
    *(LAS u32x4*)(Kb + row * NSA_KS + ch * 8) = kr;
    if (VMODE == 1) { *(LAS u32x2*)(Vb + row * NSA_VS + ch * 8) = (u32x2){vr.x, vr.y}; *(LAS u32x2*)(Vb + row * NSA_VS + ch * 8 + 4) = (u32x2){vr.z, vr.w}; }
    if (VMODE == 2) { LAS bf16* vp = Vb + (8 * ch) * NSA_VS + row;
        vp[0] = (bf16)(vr.x & 0xffffu); vp[NSA_VS] = (bf16)(vr.x >> 16); vp[2 * NSA_VS] = (bf16)(vr.y & 0xffffu); vp[3 * NSA_VS] = (bf16)(vr.y >> 16);
        vp[4 * NSA_VS] = (bf16)(vr.z & 0xffffu); vp[5 * NSA_VS] = (bf16)(vr.z >> 16); vp[6 * NSA_VS] = (bf16)(vr.w & 0xffffu); vp[7 * NSA_VS] = (bf16)(vr.w >> 16); }
}
DI void nsa_scores(const LAS bf16* Kb, const bf16x8 (&qf)[4], f32x16 (&S)[2], int r32, int h2) {
#pragma unroll
    for (int kb = 0; kb < 2; ++kb) {
        f32x16 acc;
#pragma unroll
        for (int i = 0; i < 16; ++i) acc[i] = 0.f;
#pragma unroll
        for (int ks = 0; ks < 4; ++ks) { const bf16x8 a = *(const LAS bf16x8*)(Kb + (32 * kb + r32) * NSA_KS + 16 * ks + 8 * h2); acc = __builtin_amdgcn_mfma_f32_32x32x16_bf16(a, qf[ks], acc, 0, 0, 0); }
        S[kb] = acc;
    }
}
DI void nsa_tile_online(const LAS bf16* Kb, const LAS bf16* Vb, const bf16x8 (&qf)[4], bool en, int klo, int khi, float& m, float& l, f32x16 (&O)[2], int r32, int h2) {
    f32x16 S[2]; nsa_scores(Kb, qf, S, r32, h2);
    const bool full = __all(en && klo <= 0 && khi >= 63);
    if (!full) {
#pragma unroll
        for (int kb = 0; kb < 2; ++kb)
#pragma unroll
            for (int r = 0; r < 16; ++r) { const int kk = 32 * kb + crow16(r, h2); const bool ok = en && kk >= klo && kk <= khi; S[kb][r] = ok ? S[kb][r] : -1e30f; }
    }
    float mx = -1e30f;
#pragma unroll
    for (int kb = 0; kb < 2; ++kb)
#pragma unroll
        for (int r = 0; r < 16; ++r) mx = fmaxf(mx, S[kb][r]);
    mx = fmaxf(mx, __shfl_xor(mx, 32));
    const float mn = fmaxf(m, mx), corr = __expf(m - mn), mref = fmaxf(mn, -1e29f);
    float ls = 0.f;
#pragma unroll
    for (int kb = 0; kb < 2; ++kb)
#pragma unroll
        for (int r = 0; r < 16; ++r) { const float p = __expf(S[kb][r] - mref); S[kb][r] = p; ls += p; }
    ls += __shfl_xor(ls, 32);
    l = l * corr + ls; m = mn;
#pragma unroll
    for (int i = 0; i < 2; ++i)
#pragma unroll
        for (int r = 0; r < 16; ++r) O[i][r] *= corr;
#pragma unroll
    for (int st = 0; st < 4; ++st) {
        const int kb = st >> 1, r0 = 8 * (st & 1);
        u32x4 pk; pk.x = pg8::cvt_pk_bf16(S[kb][r0], S[kb][r0 + 1]); pk.y = pg8::cvt_pk_bf16(S[kb][r0 + 2], S[kb][r0 + 3]); pk.z = pg8::cvt_pk_bf16(S[kb][r0 + 4], S[kb][r0 + 5]); pk.w = pg8::cvt_pk_bf16(S[kb][r0 + 6], S[kb][r0 + 7]);
        const bf16x8 pb = __builtin_bit_cast(bf16x8, pk);
#pragma unroll
        for (int i = 0; i < 2; ++i) {
            const LAS bf16* vp = Vb + (32 * i + r32) * NSA_VS + 16 * st + 4 * h2;
            const u32x2 lo = *(const LAS u32x2*)vp, hi = *(const LAS u32x2*)(vp + 8);
            const bf16x8 va = __builtin_bit_cast(bf16x8, (u32x4){lo.x, lo.y, hi.x, hi.y});
            O[i] = __builtin_amdgcn_mfma_f32_32x32x16_bf16(va, pb, O[i], 0, 0, 0);
        }
    }
}
DI void nsa_tile_imp(const LAS bf16* Kb, const bf16x8 (&qf)[4], int khi, float m, float invl, LAS float* improw, int jbase, int r32, int h2) {
    f32x16 S[2]; nsa_scores(Kb, qf, S, r32, h2);
    const float mref = fmaxf(m, -1e29f);
#pragma unroll
    for (int kb = 0; kb < 2; ++kb)
#pragma unroll
        for (int rg = 0; rg < 4; ++rg) {
            float p[4];
#pragma unroll
            for (int e = 0; e < 4; ++e) { const int kk = 32 * kb + 8 * rg + 4 * h2 + e; p[e] = (kk <= khi) ? __expf(S[kb][4 * rg + e] - mref) * invl : 0.f; }
            float a = p[0] + p[1] + p[2] + 0.5f * p[3], c = 0.5f * p[3];
            a += __shfl_xor(a, 1); a += __shfl_xor(a, 2); c += __shfl_xor(c, 1); c += __shfl_xor(c, 2);
            if ((r32 & 3) == 0) { const int j = jbase + 8 * kb + 2 * rg + h2;
                __hip_atomic_fetch_add(improw + j, a, __ATOMIC_RELAXED, __HIP_MEMORY_SCOPE_WORKGROUP);
                if (j < 63) __hip_atomic_fetch_add(improw + j + 1, c, __ATOMIC_RELAXED, __HIP_MEMORY_SCOPE_WORKGROUP); }
        }
}
template <int MODE>
DI void nsa_branch(LAS unsigned char* lds, u64 list, const bf16* Kg0, const bf16* Vg0, size_t ldv, const bf16x8 (&qf)[4], int tpos, int cmax, u64 mymask, u64 wun,
                   float& m, float& l, f32x16 (&O)[2], LAS float* improw, int tid, int r32, int h2) {
    constexpr int NEEDV = (MODE == 1) ? 0 : (MODE == 0 ? 1 : 2);
    if (list == 0) return;
    u32x4 kr, vr; vr = (u32x4){0u, 0u, 0u, 0u};
    int j = __builtin_ctzll(list); u64 rem = list & (list - 1); int idx = 0;
    nsa_ld<NEEDV>(kr, vr, Kg0 + (size_t)j * 4096, Vg0 + (size_t)j * (NEEDV == 2 ? 4096 : 64), ldv, tid);
    nsa_st<NEEDV>((LAS bf16*)(lds + NSA_K0), (LAS bf16*)(lds + NSA_V0), kr, vr, tid);
    __syncthreads();
    const float invl = (MODE == 1 && l > 0.f) ? 1.0f / l : 0.f;
    for (;;) {
        const bool hasnext = rem != 0; const int jn = hasnext ? __builtin_ctzll(rem) : 0;
        if (hasnext) nsa_ld<NEEDV>(kr, vr, Kg0 + (size_t)jn * 4096, Vg0 + (size_t)jn * (NEEDV == 2 ? 4096 : 64), ldv, tid);
        const LAS bf16* Kb = (const LAS bf16*)(lds + ((idx & 1) ? NSA_K1 : NSA_K0)); const LAS bf16* Vb = (const LAS bf16*)(lds + ((idx & 1) ? NSA_V1 : NSA_V0));
        if (MODE == 0) nsa_tile_online(Kb, Vb, qf, true, 0, cmax - 64 * j, m, l, O, r32, h2);
        if (MODE == 1) nsa_tile_imp(Kb, qf, cmax - 64 * j, m, invl, improw, 16 * j, r32, h2);
        if (MODE == 2) { if ((wun >> j) & 1ull) nsa_tile_online(Kb, Vb, qf, ((mymask >> j) & 1ull) != 0ull, 0, tpos - 64 * j, m, l, O, r32, h2); }
        if (MODE == 3) nsa_tile_online(Kb, Vb, qf, true, tpos - 511 - 64 * j, tpos - 64 * j, m, l, O, r32, h2);
        if (hasnext) nsa_st<NEEDV>((LAS bf16*)(lds + ((idx & 1) ? NSA_K0 : NSA_K1)), (LAS bf16*)(lds + ((idx & 1) ? NSA_V0 : NSA_V1)), kr, vr, tid);
        __syncthreads();
        if (!hasnext) break;
        j = jn; rem &= rem - 1; ++idx;
    }
}
DI void nsa_fold(f32x16 (&res)[2], const f32x16 (&O)[2], float l, float gate) {
    const float f = l > 0.f ? gate / l : 0.f;
#pragma unroll
    for (int i = 0; i < 2; ++i)
#pragma unroll
        for (int r = 0; r < 16; ++r) res[i][r] += f * O[i][r];
}
DI void phase_nsa(const Ctx& C) {
    const int tid = C.tid, lane = C.lane, r32 = lane & 31, h2 = lane >> 5, w = C.wave;
    const bf16* QN = WSP(bf16, R_QN); const bf16* QR = WSP(bf16, R_QR); const float* GATES = WSP(float, R_GATES); bf16* MIXIN = WSP(bf16, WS_MIXIN);
    LAS float* IMP = (LAS float*)(C.lds + NSA_IMP); LAS u64* TMASK = (LAS u64*)(C.lds + NSA_TMASK); LAS u64* WUN = (LAS u64*)(C.lds + NSA_WUN);
    for (int u = C.bid; u < 1024; u += C.G) {
        const int r = u >> 8, cc = u & 255, bg = cc & 15, qslot = cc >> 4;
        const int qb = (r & 1) ? (16 * r + 15 - qslot) : (16 * r + qslot);
        const int b = bg >> 1, g = bg & 1, s0 = 64 * qb;
        const int tl = 8 * w + (r32 >> 2), hh = r32 & 3, tpos = s0 + tl; const size_t t = (size_t)b * SEQ + tpos;
        const int cmax = tpos >= 31 ? ((tpos - 31) >> 4) : -1;
        LAS float* improw = IMP + tl * 64;
        { LAS f32x4* z = (LAS f32x4*)(IMP + 8 * w * 64); z[lane] = (f32x4){0.f, 0.f, 0.f, 0.f}; z[lane + 64] = (f32x4){0.f, 0.f, 0.f, 0.f}; }
        bf16x8 qf[4];
#pragma unroll
        for (int ks = 0; ks < 4; ++ks) qf[ks] = *(const bf16x8*)(QN + t * 512 + (g * 4 + hh) * 64 + 16 * ks + 8 * h2);
        f32x16 res[2], O[2];
#pragma unroll
        for (int i = 0; i < 2; ++i)
#pragma unroll
            for (int k = 0; k < 16; ++k) { res[i][k] = 0.f; O[i][k] = 0.f; }
        float m = -1e30f, l = 0.f;
        const float* gp = GATES + t * 24 + g * 12 + hh * 3;
        const int nct = (4 * qb + 3 + 63) >> 6; const u64 clist = (1ull << nct) - 1ull;
        const bf16* KCb = WSP(bf16, R_KC) + (size_t)bg * 256 * 64; const bf16* VCTb = WSP(bf16, R_VC) + (size_t)bg * 64 * 256;
        nsa_branch<0>(C.lds, clist, KCb, VCTb, 256, qf, tpos, cmax, 0ull, 0ull, m, l, O, improw, tid, r32, h2);
        nsa_fold(res, O, l, gp[0]);
        nsa_branch<1>(C.lds, clist, KCb, VCTb, 256, qf, tpos, cmax, 0ull, 0ull, m, l, O, improw, tid, r32, h2);
        const u64 upto = (qb == 63) ? ~0ull : ((2ull << qb) - 1ull);
        u64 wun = 0ull;
        for (int i = 0; i < 8; ++i) {
            const float sc = IMP[(8 * w + i) * 64 + lane];
            const bool forced = (lane == 0) || (lane == qb) || (lane == qb - 1);
            const float score = forced ? 1e4f : (lane <= qb ? sc : -1.0f);
            int rank = 0;
#pragma unroll 8
            for (int k = 0; k < 64; ++k) { const float sk = rdlane(score, k); rank += (sk > score || (sk == score && k < lane)) ? 1 : 0; }
            const u64 msk = __ballot(rank < 16) & upto;
            if (lane == 0) TMASK[8 * w + i] = msk;
            wun |= msk;
        }
        if (lane == 0) WUN[w] = wun;
        __syncthreads();
        const u64 mymask = TMASK[tl];
        u64 un = 0ull;
#pragma unroll
        for (int i = 0; i < 8; ++i) un |= WUN[i];
        un = ((u64)__builtin_amdgcn_readfirstlane((unsigned)(un >> 32)) << 32) | (u64)__builtin_amdgcn_readfirstlane((unsigned)un);
#pragma unroll
        for (int ks = 0; ks < 4; ++ks) qf[ks] = *(const bf16x8*)(QR + t * 512 + (g * 4 + hh) * 64 + 16 * ks + 8 * h2);
#pragma unroll
        for (int i = 0; i < 2; ++i)
#pragma unroll
            for (int k = 0; k < 16; ++k) O[i][k] = 0.f;
        m = -1e30f; l = 0.f;
        nsa_branch<2>(C.lds, un, WSP(bf16, R_KSLC) + (size_t)bg * SEQ * 64, WSP(bf16, R_VSLC) + (size_t)bg * SEQ * 64, 64, qf, tpos, cmax, mymask, wun, m, l, O, improw, tid, r32, h2);
        nsa_fold(res, O, l, gp[1]);
#pragma unroll
        for (int i = 0; i < 2; ++i)
#pragma unroll
            for (int k = 0; k < 16; ++k) O[i][k] = 0.f;
        m = -1e30f; l = 0.f;
        const int jlo = qb - 8 > 0 ? qb - 8 : 0; const u64 wlist = upto & ~((1ull << jlo) - 1ull);
        nsa_branch<3>(C.lds, wlist, WSP(bf16, R_KWIN) + (size_t)bg * SEQ * 64, WSP(bf16, R_VWIN) + (size_t)bg * SEQ * 64, 64, qf, tpos, cmax, 0ull, 0ull, m, l, O, improw, tid, r32, h2);
        nsa_fold(res, O, l, gp[2]);
        bf16* orow = MIXIN + t * 1024 + (g * 4 + hh) * 64;
#pragma unroll
        for (int i = 0; i < 2; ++i)
#pragma unroll
            for (int rg = 0; rg < 4; ++rg) { u32x2 o2; o2.x = pg8::cvt_pk_bf16(res[i][4 * rg], res[i][4 * rg + 1]); o2.y = pg8::cvt_pk_bf16(res[i][4 * rg + 2], res[i][4 * rg + 3]);
                *(u32x2*)(orow + 32 * i + 8 * rg + 4 * h2) = o2; }
    }
}

DI void phase_sgu(const Ctx& C) {
    const int lane = C.lane, r32 = lane & 31, h2 = lane >> 5, w = C.wave, tid = C.tid;
    const bf16* SGW = WSP(bf16, WS_SGW); const bf16* VN = WSP(bf16, R_VN); const bf16* UG = WSP(bf16, R_UG); const float* sb = INP(float, 10); bf16* MIXIN = WSP(bf16, WS_MIXIN);
    LAS bf16* vt = (LAS bf16*)C.lds;
    for (int unit = C.bid; unit < 1024; unit += C.G) {
        const int g = unit & 3, n = (unit >> 2) & 31, b = unit >> 7;
        const size_t tok0 = (size_t)b * SEQ + n * 128;
#pragma unroll
        for (int i = 0; i < 4; ++i) { const int idx = tid + NTHREADS * i, row = idx >> 4, ch = idx & 15; *(LAS u32x4*)(vt + row * 136 + 8 * ch) = *(const u32x4*)(VN + (tok0 + row) * 512 + g * 128 + 8 * ch); }
        __syncthreads();
#pragma unroll
        for (int rep = 0; rep < 2; ++rep) {
            const int tile = w + 8 * rep, ti = tile >> 2, ci = tile & 3, nks = 2 * ti + 2;
            f32x16 acc;
#pragma unroll
            for (int i = 0; i < 16; ++i) acc[i] = 0.f;
            const bf16* ap = SGW + (size_t)(g * 128 + 32 * ti + r32) * 128 + 8 * h2; const LAS bf16* bp = vt + (8 * h2) * 136 + 32 * ci + r32;
            for (int ks = 0; ks < nks; ++ks) { const bf16x8 av = *(const bf16x8*)(ap + 16 * ks); const LAS bf16* q = bp + (16 * ks) * 136;
                u32x4 bw; bw.x = (unsigned)q[0] | ((unsigned)q[136] << 16); bw.y = (unsigned)q[272] | ((unsigned)q[408] << 16); bw.z = (unsigned)q[544] | ((unsigned)q[680] << 16); bw.w = (unsigned)q[816] | ((unsigned)q[952] << 16);
                acc = __builtin_amdgcn_mfma_f32_32x32x16_bf16(av, __builtin_bit_cast(bf16x8, bw), acc, 0, 0, 0); }
            const int cidx = g * 128 + 32 * ci + r32;
#pragma unroll
            for (int rg = 0; rg < 16; ++rg) { const int tt = 32 * ti + crow16(rg, h2); const size_t tok = tok0 + tt;
                MIXIN[tok * 1024 + 512 + cidx] = (bf16)f2bf(bf2f(UG[tok * 512 + cidx]) * (acc[rg] + sb[g * 128 + tt])); }
        }
        __syncthreads();
    }
}

DI void ln_row_finish(f32x4 (&v)[4], const float* gam, const float* bet, float* xo, bf16* xb, int lane) {
    float s = 0.f;
#pragma unroll
    for (int j = 0; j < 4; ++j) s += (v[j][0] + v[j][1]) + (v[j][2] + v[j][3]);
    const float mean = wave_sum(s) * (1.0f / DM); float s2 = 0.f;
#pragma unroll
    for (int j = 0; j < 4; ++j) { v[j] = v[j] - mean; s2 += (v[j][0] * v[j][0] + v[j][1] * v[j][1]) + (v[j][2] * v[j][2] + v[j][3] * v[j][3]); }
    const float rstd = 1.0f / sqrtf(wave_sum(s2) * (1.0f / DM) + 1e-5f);
#pragma unroll
    for (int j = 0; j < 4; ++j) { const f32x4 gg = ((const f32x4*)gam)[lane + 64 * j], bb = ((const f32x4*)bet)[lane + 64 * j];
        const f32x4 r = v[j] * rstd * gg + bb; ((f32x4*)xo)[lane + 64 * j] = r;
        u32x2 w; w.x = pk2(r[0], r[1]); w.y = pk2(r[2], r[3]); ((u32x2*)xb)[lane + 64 * j] = w; }
}
DI void phase_ln(const Ctx& C, const float* xprev, const float* y, const float* gam, const float* bet, float* xnext, bf16* xb) {
    for (int t = C.gw; t < T; t += C.NGW) {
        f32x4 v[4];
#pragma unroll
        for (int j = 0; j < 4; ++j) v[j] = ((const f32x4*)(xprev + (size_t)t * DM))[C.lane + 64 * j] * ALPHA + ((const f32x4*)(y + (size_t)t * DM))[C.lane + 64 * j];
        ln_row_finish(v, gam, bet, xnext + (size_t)t * DM, xb + (size_t)t * DM, C.lane);
    }
}

DI void phase_xattn(const Ctx& C, int layer) {
    const int lane = C.lane;
    LAS float* qs = (LAS float*)(C.lds + C.wave * 16384);
    const bf16* XQ = WSP(bf16, WS_XQ); const bf16* XKV = WSP(bf16, WS_XKV) + (size_t)layer * 2048 * 2048; bf16* XO = WSP(bf16, WS_XO);
    for (int it0 = C.gw; it0 < T * 4; it0 += C.NGW) {
        const int it = __builtin_amdgcn_readfirstlane(it0);
        const int h = it & 3, t = it >> 2, b = t / SEQ;
#pragma unroll
        for (int r = 0; r < 4; ++r) qs[lane + 64 * r] = bf2f(XQ[(size_t)t * 1024 + h * 256 + lane + 64 * r]) * 0.0625f;
        LDS_WAIT();
        float o[1][4] = {{0.f, 0.f, 0.f, 0.f}}, m[1] = {-1e30f}, l[1] = {0.f};
        const bf16* Kb = XKV + (size_t)b * 256 * 2048 + h * 256;
        wave_attn_blocks<256, 1>(qs, Kb, 2048, Kb + 1024, 2048, 0xFull, 1 << 29, 1 << 30, o, m, l, lane);
        const float inv = 1.0f / l[0];
#pragma unroll
        for (int r = 0; r < 4; ++r) XO[(size_t)t * 1024 + h * 256 + lane + 64 * r] = (bf16)f2bf(o[0][r] * inv);
    }
}

DI void phase_router(const Ctx& C, int layer, const float* x) {
    const int lane = C.lane, r32 = lane & 31, h2 = lane >> 5, w = C.wave;
    unsigned char* tab = C.ws + WS_MOETAB + (size_t)layer * 2 * MiB;
    int* TOKE = (int*)(tab + MT_TOKE); float* TOKG = (float*)(tab + MT_TOKG); int* HIST = (int*)(tab + MT_HIST);
    const float* rw = INP(float, 23) + (size_t)layer * 1024 * 32; const float* rb = INP(float, 24) + layer * 32;
    LAS int* hist = (LAS int*)(C.lds);
    for (int chunk = C.bid; chunk < 256; chunk += C.G) {
        if (C.tid < 32) hist[C.tid] = 0;
        __syncthreads();
        if (w < 4) {
            const int tb = chunk * 128 + w * 32;
            const float* xr = x + (size_t)(tb + r32) * DM + 4 * h2; const float* wp = rw + (size_t)(4 * h2) * 32 + r32;
            f32x16 acc;
#pragma unroll
            for (int i = 0; i < 16; ++i) acc[i] = 0.f;
#pragma unroll 4
            for (int kb = 0; kb < 1024; kb += 8) {
                const f32x4 xa = *(const f32x4*)(xr + kb);
                const float w0 = wp[(size_t)(kb + 0) * 32], w1 = wp[(size_t)(kb + 1) * 32], w2 = wp[(size_t)(kb + 2) * 32], w3 = wp[(size_t)(kb + 3) * 32];
                acc = __builtin_amdgcn_mfma_f32_32x32x2f32(xa[0], w0, acc, 0, 0, 0); acc = __builtin_amdgcn_mfma_f32_32x32x2f32(xa[1], w1, acc, 0, 0, 0);
                acc = __builtin_amdgcn_mfma_f32_32x32x2f32(xa[2], w2, acc, 0, 0, 0); acc = __builtin_amdgcn_mfma_f32_32x32x2f32(xa[3], w3, acc, 0, 0, 0);
            }
            const float bias = rb[r32];
#pragma unroll
            for (int rg = 0; rg < 16; ++rg) {
                const int t = tb + crow16(rg, h2);
                float val = acc[rg] + bias; float tv[4]; int ti[4];
#pragma unroll
                for (int r = 0; r < 4; ++r) {
                    float best = val; int bi = r32;
#pragma unroll
                    for (int off = 16; off >= 1; off >>= 1) { const float ov = __shfl_xor(best, off); const int oi = __shfl_xor(bi, off); if (ov > best || (ov == best && oi < bi)) { best = ov; bi = oi; } }
                    tv[r] = best; ti[r] = bi; if (r32 == bi) val = -3.0e38f;
                }
                const float e1 = __expf(tv[1] - tv[0]), e2 = __expf(tv[2] - tv[0]), e3 = __expf(tv[3] - tv[0]); const float inv = 1.0f / (1.0f + e1 + e2 + e3);
                if (r32 == 0) {
                    *(i32x4*)(TOKE + (size_t)t * 4) = (i32x4){ti[0], ti[1], ti[2], ti[3]};
                    *(f32x4*)(TOKG + (size_t)t * 4) = (f32x4){inv, e1 * inv, e2 * inv, e3 * inv};
                    __hip_atomic_fetch_add(hist + ti[0], 1, __ATOMIC_RELAXED, __HIP_MEMORY_SCOPE_WORKGROUP); __hip_atomic_fetch_add(hist + ti[1], 1, __ATOMIC_RELAXED, __HIP_MEMORY_SCOPE_WORKGROUP);
                    __hip_atomic_fetch_add(hist + ti[2], 1, __ATOMIC_RELAXED, __HIP_MEMORY_SCOPE_WORKGROUP); __hip_atomic_fetch_add(hist + ti[3], 1, __ATOMIC_RELAXED, __HIP_MEMORY_SCOPE_WORKGROUP);
                }
            }
        }
        __syncthreads();
        if (C.tid < 32) HIST[chunk * 32 + C.tid] = hist[C.tid];
        __syncthreads();
    }
}
DI void phase_moe_scatter(const Ctx& C, int layer) {
    const int lane = C.lane, tid = C.tid;
    unsigned char* tab = C.ws + WS_MOETAB + (size_t)layer * 2 * MiB;
    const int* TOKE = (const int*)(tab + MT_TOKE); int* TOKSLOT = (int*)(tab + MT_TOKSLOT); const int* HIST = (const int*)(tab + MT_HIST); int* TILEE = (int*)(tab + MT_TILEE);
    const bf16* XB = WSP(bf16, WS_XB); bf16* XG = WSP(bf16, R_XG);
    LAS int* hl = (LAS int*)(C.lds);
    LAS int* tot = hl + 8192;
    LAS int* ebase = tot + 32;
    LAS int* cntl = tot + 96;
    LAS int* slots = tot + 128;
    for (int i = tid; i < 2048; i += NTHREADS) ((LAS i32x4*)hl)[i] = ((const i32x4*)HIST)[i];
    __syncthreads();
    if (tid < 32) { int s = 0; for (int c = 0; c < 256; ++c) { const int v = hl[c * 32 + tid]; hl[c * 32 + tid] = s; s += v; } tot[tid] = s; }
    __syncthreads();
    if (tid == 0) { int acc = 0; for (int e = 0; e < 32; ++e) { ebase[e] = acc; acc += (tot[e] + 255) & ~255; } ebase[32] = acc; }
    __syncthreads();
    if (C.bid == 0) { const int nmt = ebase[32] >> 8; for (int mt = tid; mt < nmt; mt += NTHREADS) { int e = 0; while (e < 31 && (mt << 8) >= ebase[e + 1]) ++e; TILEE[mt] = e; } if (tid == 0) TILEE[1023] = nmt; }
    for (int e = C.bid; e < 32; e += C.G) { const int r0 = ebase[e] + tot[e], r1 = ebase[e + 1];
        for (int r = r0 + C.wave; r < r1; r += NWAVES) { u32x4* p = (u32x4*)(XG + (size_t)r * 1024); p[lane] = (u32x4){0u, 0u, 0u, 0u}; p[lane + 64] = (u32x4){0u, 0u, 0u, 0u}; } }
    for (int chunk = C.bid; chunk < 256; chunk += C.G) {
        __syncthreads();
        if (tid < 32) cntl[tid] = ebase[tid] + hl[chunk * 32 + tid];
        __syncthreads();
        if (C.wave == 0) {
            for (int bt = 0; bt < 8; ++bt) {
                const int idx = bt * 64 + lane; const int my_e = TOKE[(size_t)chunk * 512 + idx];
                int slot = 0;
                for (int e = 0; e < 32; ++e) { const u64 mm = __ballot(my_e == e); if (mm) { const int base = cntl[e]; if (my_e == e) slot = base + __popcll(mm & ((1ull << lane) - 1ull)); LDS_WAIT(); if (lane == 0) cntl[e] = base + __popcll(mm); LDS_WAIT(); } }
                slots[idx] = slot; TOKSLOT[(size_t)chunk * 512 + idx] = slot;
            }
        }
        __syncthreads();
        for (int i = C.wave; i < 512; i += NWAVES) { const int t = chunk * 128 + (i >> 2); const int slot = slots[i];
            const u32x4* src = (const u32x4*)(XB + (size_t)t * 1024); u32x4* dst = (u32x4*)(XG + (size_t)slot * 1024);
            dst[lane] = src[lane]; dst[lane + 64] = src[lane + 64]; }
    }
}
DI void phase_moe_combine_ln(const Ctx& C, int layer, const float* xprev, const float* gam, const float* bet, float* xnext, bf16* xb) {
    unsigned char* tab = C.ws + WS_MOETAB + (size_t)layer * 2 * MiB;
    const float* TOKG = (const float*)(tab + MT_TOKG); const int* TOKSLOT = (const int*)(tab + MT_TOKSLOT); const bf16* YEXP = WSP(bf16, R_YEXP);
    for (int t = C.gw; t < T; t += C.NGW) {
        f32x4 v[4];
#pragma unroll
        for (int j = 0; j < 4; ++j) v[j] = ((const f32x4*)(xprev + (size_t)t * DM))[C.lane + 64 * j] * ALPHA;
#pragma unroll
        for (int r = 0; r < 4; ++r) { const float gt = TOKG[t * 4 + r]; const int slot = TOKSLOT[t * 4 + r]; const u32x2* yr = (const u32x2*)(YEXP + (size_t)slot * 1024);
#pragma unroll
            for (int j = 0; j < 4; ++j) { const u32x2 w = yr[C.lane + 64 * j];
                v[j][0] += gt * __uint_as_float(w.x << 16); v[j][1] += gt * __uint_as_float(w.x & 0xffff0000u); v[j][2] += gt * __uint_as_float(w.y << 16); v[j][3] += gt * __uint_as_float(w.y & 0xffff0000u); } }
        ln_row_finish(v, gam, bet, xnext + (size_t)t * DM, xb + (size_t)t * DM, C.lane);
    }
}

constexpr size_t R_UT = WS_R1 + 224 * MiB, R_SST = WS_R1 + 352 * MiB, R_QT = WS_R1 + 416 * MiB, R_DEC = WS_R1 + 448 * MiB;
constexpr int HG_QS = 136, HG_TS = 72;
constexpr int HG_QT = 0, HG_KT = 17408, HG_KDT = 34816, HG_VT = 53248, HG_PM = 71680, HG_PART = 80896;
DI void phase_hgrn_conv(const Ctx& C) {
    const int lane = C.lane; const bf16* PROJ = WSP(bf16, R_PROJ); bf16* MIXIN = WSP(bf16, WS_MIXIN);
    const float* cw = INP(float, 15); const float* cb = INP(float, 16);
    for (int t = C.gw; t < T; t += C.NGW) {
        const int s = t % SEQ; const bf16* pr = PROJ + (size_t)t * ODD_IN;
#pragma unroll
        for (int j = 0; j < 8; ++j) {
            const int c = lane + 64 * j;
            const float z0 = bf2f(pr[3072 + c]) * bf2f(pr[2048 + c]);
            const float z1 = s >= 1 ? bf2f(pr[3072 + c - ODD_IN]) * bf2f(pr[2048 + c - ODD_IN]) : 0.f;
            const float z2 = s >= 2 ? bf2f(pr[3072 + c - 2 * ODD_IN]) * bf2f(pr[2048 + c - 2 * ODD_IN]) : 0.f;
            const float y = cw[c] * z2 + cw[512 + c] * z1 + cw[1024 + c] * z0 + cb[c];
            MIXIN[(size_t)t * 1024 + 512 + c] = (bf16)f2bf(bf2f(pr[2560 + c]) * y);
        }
    }
}
DI void phase_hgrn_h1(const Ctx& C) {
    const int tid = C.tid, lane = C.lane, r32 = lane & 31, h2 = lane >> 5, w = C.wave;
    const bf16* PROJ = WSP(bf16, R_PROJ); const float* lbl = INP(float, 13);
    float* ORAW = WSP(float, R_ORAW); float* UT = WSP(float, R_UT); bf16* QTg = WSP(bf16, R_QT); float* DEC = WSP(float, R_DEC);
    LAS bf16* Qt = (LAS bf16*)(C.lds + HG_QT); LAS bf16* Kt = (LAS bf16*)(C.lds + HG_KT); LAS bf16* KdT = (LAS bf16*)(C.lds + HG_KDT); LAS bf16* VT = (LAS bf16*)(C.lds + HG_VT);
    LAS bf16* Pm = (LAS bf16*)(C.lds + HG_PM); LAS float* part = (LAS float*)(C.lds + HG_PART);
    const int k = tid & 127, tq = tid >> 7;
    for (int unit = C.bid; unit < 2048; unit += C.G) {
        const int c = unit & 63, bh = unit >> 6, h = bh & 3, b = bh >> 2;
        const size_t t0 = (size_t)b * SEQ + 64 * c;
        const float l0 = lbl[h * 128 + k], l1 = lbl[512 + h * 128 + k]; const float lbk = 1.0f / (1.0f + __expf(l0 - l1));
        float bl[16], kk[16]; float run = 0.f;
#pragma unroll
        for (int i = 0; i < 16; ++i) {
            const float z = bf2f(PROJ[(t0 + 16 * tq + i) * ODD_IN + 512 + h * 128 + k]);
            const float sg = 1.0f / (1.0f + __expf(-z)); const float f = lbk + (1.0f - lbk) * sg;
            run += __logf(f); bl[i] = run; kk[i] = (1.0f - lbk) * (1.0f - sg);
        }
        part[tq * 128 + k] = run;
        __syncthreads();
        float off = 0.f, blast = 0.f;
#pragma unroll
        for (int q = 0; q < 4; ++q) { const float pv = part[q * 128 + k]; blast += pv; off += (q < tq) ? pv : 0.f; }
        unsigned kdp[8], vtp[8];
#pragma unroll
        for (int i = 0; i < 16; ++i) {
            const int t = 16 * tq + i; const float bb = bl[i] + off; const float eb = __expf(bb);
            const float qv = bf2f(PROJ[(t0 + t) * ODD_IN + h * 128 + k]);
            const unsigned qt = f2bf(qv * eb);
            Qt[t * HG_QS + k] = (bf16)qt; QTg[(t0 + t) * 512 + h * 128 + k] = (bf16)qt;
            Kt[t * HG_QS + k] = (bf16)f2bf(kk[i] * __expf(-bb));
            const unsigned kd = f2bf(kk[i] * __expf(blast - bb)); const unsigned vv = PROJ[(t0 + t) * ODD_IN + 1024 + h * 128 + k];
            if (i & 1) { kdp[i >> 1] |= kd << 16; vtp[i >> 1] |= vv << 16; } else { kdp[i >> 1] = kd; vtp[i >> 1] = vv; }
        }
        *(LAS u32x4*)(KdT + k * HG_TS + 16 * tq) = (u32x4){kdp[0], kdp[1], kdp[2], kdp[3]}; *(LAS u32x4*)(KdT + k * HG_TS + 16 * tq + 8) = (u32x4){kdp[4], kdp[5], kdp[6], kdp[7]};
        *(LAS u32x4*)(VT + k * HG_TS + 16 * tq) = (u32x4){vtp[0], vtp[1], vtp[2], vtp[3]}; *(LAS u32x4*)(VT + k * HG_TS + 16 * tq + 8) = (u32x4){vtp[4], vtp[5], vtp[6], vtp[7]};
        if (tq == 0) DEC[(size_t)unit * 128 + k] = __expf(blast);
        __syncthreads();
        if (w < 4) {
            const int si = w >> 1, ti = w & 1;
            if (si <= ti) {
                f32x16 acc;
#pragma unroll
                for (int i = 0; i < 16; ++i) acc[i] = 0.f;
#pragma unroll
                for (int ks = 0; ks < 8; ++ks) { const bf16x8 av = *(const LAS bf16x8*)(Kt + (32 * si + r32) * HG_QS + 16 * ks + 8 * h2), bv = *(const LAS bf16x8*)(Qt + (32 * ti + r32) * HG_QS + 16 * ks + 8 * h2);
                    acc = __builtin_amdgcn_mfma_f32_32x32x16_bf16(av, bv, acc, 0, 0, 0); }
                const int tt = 32 * ti + r32;
#pragma unroll
                for (int rg = 0; rg < 4; ++rg) { const int s0 = 32 * si + 8 * rg + 4 * h2; float v4[4];
#pragma unroll
                    for (int e = 0; e < 4; ++e) v4[e] = (s0 + e <= tt) ? acc[4 * rg + e] : 0.f;
                    *(LAS u32x2*)(Pm + tt * HG_TS + s0) = (u32x2){pk2(v4[0], v4[1]), pk2(v4[2], v4[3])}; }
            }
        }
        __syncthreads();
        {
            const int ti = w >> 2, vi = w & 3; const int nks = ti ? 4 : 2;
            f32x16 acc;
#pragma unroll
            for (int i = 0; i < 16; ++i) acc[i] = 0.f;
            for (int ks = 0; ks < nks; ++ks) { const bf16x8 av = *(const LAS bf16x8*)(Pm + (32 * ti + r32) * HG_TS + 16 * ks + 8 * h2), bv = *(const LAS bf16x8*)(VT + (32 * vi + r32) * HG_TS + 16 * ks + 8 * h2);
                acc = __builtin_amdgcn_mfma_f32_32x32x16_bf16(av, bv, acc, 0, 0, 0); }
#pragma unroll
            for (int rg = 0; rg < 16; ++rg) ORAW[(t0 + 32 * ti + crow16(rg, h2)) * 512 + h * 128 + 32 * vi + r32] = acc[rg];
        }
#pragma unroll
        for (int rep = 0; rep < 2; ++rep) {
            const int idx = w + 8 * rep, vi = idx >> 2, ki = idx & 3;
            f32x16 acc;
#pragma unroll
            for (int i = 0; i < 16; ++i) acc[i] = 0.f;
#pragma unroll
            for (int ks = 0; ks < 4; ++ks) { const bf16x8 av = *(const LAS bf16x8*)(VT + (32 * vi + r32) * HG_TS + 16 * ks + 8 * h2), bv = *(const LAS bf16x8*)(KdT + (32 * ki + r32) * HG_TS + 16 * ks + 8 * h2);
                acc = __builtin_amdgcn_mfma_f32_32x32x16_bf16(av, bv, acc, 0, 0, 0); }
#pragma unroll
            for (int rg = 0; rg < 16; ++rg) UT[(size_t)unit * 16384 + (32 * vi + crow16(rg, h2)) * 128 + 32 * ki + r32] = acc[rg];
        }
        __syncthreads();
    }
}
DI void phase_hgrn_h2(const Ctx& C) {
    const float* UT = WSP(float, R_UT); const float* DEC = WSP(float, R_DEC); bf16* SST = WSP(bf16, R_SST);
    for (int idx = C.bid * NTHREADS + C.tid; idx < 32 * 16384; idx += C.G * NTHREADS) {
        const int bh = idx >> 14, vk = idx & 16383, k = vk & 127;
        float S = 0.f;
#pragma unroll 4
        for (int c = 0; c < 64; ++c) { const size_t u = (size_t)bh * 64 + c; SST[u * 16384 + vk] = (bf16)f2bf(S); S = DEC[u * 128 + k] * S + UT[u * 16384 + vk]; }
    }
}
DI void phase_hgrn_h3(const Ctx& C) {
    const int lane = C.lane, r32 = lane & 31, h2 = lane >> 5, w = C.wave;
    const bf16* PROJ = WSP(bf16, R_PROJ); const float* ORAW = WSP(float, R_ORAW); const bf16* QTg = WSP(bf16, R_QT); const bf16* SST = WSP(bf16, R_SST); bf16* MIXIN = WSP(bf16, WS_MIXIN); const float* ng = INP(float, 14);
    LAS float* RS = (LAS float*)(C.lds);
    for (int unit = C.bid; unit < 2048; unit += C.G) {
        const int c = unit & 63, bh = unit >> 6, h = bh & 3, b = bh >> 2;
        const size_t t0 = (size_t)b * SEQ + 64 * c;
        const int ti = w >> 2, vi = w & 3;
        f32x16 acc;
#pragma unroll
        for (int i = 0; i < 16; ++i) acc[i] = 0.f;
#pragma unroll
        for (int ks = 0; ks < 8; ++ks) { const bf16x8 av = *(const bf16x8*)(QTg + (t0 + 32 * ti + r32) * 512 + h * 128 + 16 * ks + 8 * h2), bv = *(const bf16x8*)(SST + (size_t)unit * 16384 + (32 * vi + r32) * 128 + 16 * ks + 8 * h2);
            acc = __builtin_amdgcn_mfma_f32_32x32x16_bf16(av, bv, acc, 0, 0, 0); }
        float ss[16];
#pragma unroll
        for (int rg = 0; rg < 16; ++rg) { acc[rg] += ORAW[(t0 + 32 * ti + crow16(rg, h2)) * 512 + h * 128 + 32 * vi + r32]; float q = acc[rg] * acc[rg];
            q += __shfl_xor(q, 1); q += __shfl_xor(q, 2); q += __shfl_xor(q, 4); q += __shfl_xor(q, 8); q += __shfl_xor(q, 16); ss[rg] = q; }
        if (r32 == 0) {
#pragma unroll
            for (int rg = 0; rg < 16; ++rg) RS[(32 * ti + crow16(rg, h2)) * 4 + vi] = ss[rg];
        }
        __syncthreads();
        const float gsc = ng[h * 128 + 32 * vi + r32];
#pragma unroll
        for (int rg = 0; rg < 16; ++rg) { const int tt = 32 * ti + crow16(rg, h2); const f32x4 r4 = *(const LAS f32x4*)(RS + tt * 4);
            const float rstd = 1.0f / sqrtf(((r4[0] + r4[1]) + (r4[2] + r4[3])) * (1.0f / 128.0f) + 1e-6f);
            const float gg = bf2f(PROJ[(t0 + tt) * ODD_IN + 1536 + h * 128 + 32 * vi + r32]);
            MIXIN[(t0 + tt) * 1024 + h * 128 + 32 * vi + r32] = (bf16)f2bf(acc[rg] * rstd * gsc * (gg / (1.0f + __expf(-gg)))); }
        __syncthreads();
    }
}

DI void gemm_bf16out(const Ctx& C, const bf16* A, const bf16* Bt, int M, int N, bf16* O, int ldc, float scale = 1.0f) {
    pg8::DenseOrder S; S.init(A, 1024, Bt, 1024, M, N, C.G, C.bid);
    pg8::EpiBf16 E{O, ldc, nullptr, 0, scale};
    pg8::gemm_phase<pg8::EpiBf16, pg8::DenseOrder>(C.lds, 1024, 1024, 1024, S, E);
}
DI void gemm_f32out(const Ctx& C, const bf16* A, const bf16* Bt, int M, int N, float* O, int ldc) {
    pg8::DenseOrder S; S.init(A, 1024, Bt, 1024, M, N, C.G, C.bid);
    pg8::EpiF32 E{O, ldc};
    pg8::gemm_phase<pg8::EpiF32, pg8::DenseOrder>(C.lds, 1024, 1024, 1024, S, E);
}
DI void gemm_moe_gu(const Ctx& C, int layer) {
    unsigned char* tab = C.ws + WS_MOETAB + (size_t)layer * 2 * MiB; const int* TILEE = (const int*)(tab + MT_TILEE);
    const int nmt = (int)__hip_atomic_load((const unsigned*)TILEE + 1023, __ATOMIC_RELAXED, __HIP_MEMORY_SCOPE_AGENT);
    pg8::MoeOrder S; S.init(WSP(bf16, R_XG), WSP(bf16, WS_WGU) + (size_t)layer * 32 * 2048 * 1024, 2048, TILEE, nmt, C.G, C.bid);
    pg8::EpiSwiglu E{WSP(bf16, R_ACT), INP(float, 26) + (size_t)layer * 32 * 2048};
    pg8::gemm_phase<pg8::EpiSwiglu, pg8::MoeOrder>(C.lds, 1024, 1024, 1024, S, E);
}
DI void gemm_moe_dn(const Ctx& C, int layer) {
    unsigned char* tab = C.ws + WS_MOETAB + (size_t)layer * 2 * MiB; const int* TILEE = (const int*)(tab + MT_TILEE);
    const int nmt = (int)__hip_atomic_load((const unsigned*)TILEE + 1023, __ATOMIC_RELAXED, __HIP_MEMORY_SCOPE_AGENT);
    pg8::MoeOrder S; S.init(WSP(bf16, R_ACT), WSP(bf16, WS_WDN) + (size_t)layer * 32 * 1024 * 1024, 1024, TILEE, nmt, C.G, C.bid);
    pg8::EpiBf16 E{WSP(bf16, R_YEXP), 1024, INP(float, 28) + (size_t)layer * 32 * 1024, 1024, 1.0f};
    pg8::gemm_phase<pg8::EpiBf16, pg8::MoeOrder>(C.lds, 1024, 1024, 1024, S, E);
}


DI void gemm_cmp_h1(const Ctx& C) {
    pg8::CmpH1Order S{C.G, C.bid, (const char*)WSP(bf16, R_KCMP), (const char*)WSP(bf16, R_VCMP), (const char*)WSP(bf16, WS_W1T)};
    pg8::EpiCmpH1 E{WSP(bf16, R_H1), WSP(float, WS_BP)};
    pg8::gemm_phase<pg8::EpiCmpH1, pg8::CmpH1Order>(C.lds, 1024, 2048, 2048, S, E);
}
DI void gemm_cmp_h2(const Ctx& C) {
    pg8::CmpH2Order S{C.G, C.bid, (const char*)WSP(bf16, R_H1), (const char*)WSP(bf16, WS_W2T)};
    pg8::EpiCmpOut E{WSP(bf16, R_KC), WSP(bf16, R_VC)};
    pg8::gemm_phase<pg8::EpiCmpOut, pg8::CmpH2Order>(C.lds, 256, 256, 256, S, E);
}

constexpr size_t R_PATT = WS_R1;
DI void gemm_xattn_s(const Ctx& C, int layer) {
    pg8::XattnSOrder S{C.G, C.bid, (const char*)WSP(bf16, WS_XQ), (const char*)(WSP(bf16, WS_XKV) + (size_t)layer * 2048 * 1024)};
    pg8::EpiSoftmax E{WSP(bf16, R_PATT), (LAS float*)(C.lds + LDSCTL_OFF + 1024)};
    pg8::gemm_phase<pg8::EpiSoftmax, pg8::XattnSOrder>(C.lds, 1024, 1024, 256, S, E);
}
DI void gemm_xattn_o(const Ctx& C, int layer) {
    pg8::XattnOOrder S{C.G, C.bid, (const char*)WSP(bf16, R_PATT), (const char*)(WSP(bf16, WS_XKV) + (size_t)(2 + layer) * 2048 * 1024)};
    pg8::EpiBf16 E{WSP(bf16, WS_XO), 1024, nullptr, 0, 1.0f};
    pg8::gemm_phase<pg8::EpiBf16, pg8::XattnOOrder>(C.lds, 256, 2048, 256, S, E);
}

DI void phase_proj0(const Ctx& C) {
    gemm_bf16out(C, WSP(bf16, WS_XB), WSP(bf16, WS_WEVEN), T, EVEN_PAD, WSP(bf16, R_PROJ), EVEN_PAD);
}
DI void phase_cmph_xkv(const Ctx& C) {
    if (C.G >= 64) {
        if (C.bid < 32) { pg8::CmpH1Order S{32, C.bid, (const char*)WSP(bf16, R_KCMP), (const char*)WSP(bf16, R_VCMP), (const char*)WSP(bf16, WS_W1T)};
            pg8::EpiCmpH1 E{WSP(bf16, R_H1), WSP(float, WS_BP)};
            pg8::gemm_phase<pg8::EpiCmpH1, pg8::CmpH1Order>(C.lds, 1024, 2048, 2048, S, E); }
        else { pg8::XkvOrder S{C.G - 32, C.bid - 32, (const char*)WSP(bf16, WS_MEMB), (const char*)WSP(bf16, WS_WXKV), (char*)nullptr};
            pg8::EpiXkv E{WSP(bf16, WS_XKV)};
            pg8::gemm_phase<pg8::EpiXkv, pg8::XkvOrder>(C.lds, 1024, 1024, 1024, S, E); }
    } else {
        gemm_cmp_h1(C);
        pg8::XkvOrder S{C.G, C.bid, (const char*)WSP(bf16, WS_MEMB), (const char*)WSP(bf16, WS_WXKV), (char*)nullptr};
        pg8::EpiXkv E{WSP(bf16, WS_XKV)};
        pg8::gemm_phase<pg8::EpiXkv, pg8::XkvOrder>(C.lds, 1024, 1024, 1024, S, E);
    }
}

enum { PH_CONV, PH_PROJ0, PH_PREP0, PH_CMPH, PH_CMPO, PH_CMPATT, PH_SLCWIN, PH_OUT0, PH_LN0,
       PH_XQ0, PH_XS0, PH_XO0, PH_XW0, PH_XLN0, PH_RT0, PH_SC0, PH_GU0, PH_DN0, PH_CB0,
       PH_PROJ1, PH_HPREP, PH_HSCAN, PH_HNORM, PH_OUT1, PH_LN1,
       PH_XQ1, PH_XS1, PH_XO1, PH_XW1, PH_XLN1, PH_RT1, PH_SC1, PH_GU1, PH_DN1, PH_CB1, N_PHASES };
#ifndef PHMASK
#define PHMASK 0xffffffffffffffffull
#endif
__global__ void __launch_bounds__(NTHREADS, 2) mega(Args args) {
    extern __shared__ __attribute__((aligned(16))) unsigned char lds_raw[];
    Ctx C;
    C.lds = (LAS unsigned char*)lds_raw; C.ws = args.ws; C.a = &args;
    C.tid = threadIdx.x; C.lane = C.tid & 63; C.wave = __builtin_amdgcn_readfirstlane(C.tid >> 6); C.bid = blockIdx.x; C.G = gridDim.x;
    C.gw = C.bid * NWAVES + C.wave; C.NGW = C.G * NWAVES;
    volatile LAS unsigned* MISC = (volatile LAS unsigned*)(C.lds + LDSCTL_OFF);
    for (int u = C.tid; u < 256; u += NTHREADS) MISC[u] = 0u;
    __syncthreads();
    const int lo = args.ph_lo, hi = args.ph_hi;
    XcdBarrier bar; bar.bar = (unsigned*)(C.ws + WS_CTL) + CW_BAR; bar.x = 0; bar.st = nullptr;
    if (hi - lo > 1) bar = xcd_barrier_post((unsigned*)(C.ws + WS_CTL) + CW_BAR, MISC + 8);
#define IN(k) ((((PHMASK) >> (k)) & 1ull) && lo <= (k) && (k) < hi)
#define SEAM(k) do { if (IN(k) && (k) + 1 < hi) xcd_barrier(bar); } while (0)
#ifndef DUPMASK
#define DUPMASK 0ull
#endif
#define PHASE(k, ...) if (IN(k)) { __VA_ARGS__ if (((DUPMASK) >> (k)) & 1ull) { __syncthreads(); __VA_ARGS__ } } SEAM(k);
#define PHASE_LAST(k, ...) if (IN(k)) { __VA_ARGS__ if (((DUPMASK) >> (k)) & 1ull) { __syncthreads(); __VA_ARGS__ } }
    const float* lng = INP(float, 21); const float* lnb = INP(float, 22);
    float* XA = WSP(float, WS_XA); float* XBF = WSP(float, WS_XBF); bf16* XB = WSP(bf16, WS_XB);

    PHASE(PH_CONV, phase_convert(C);)
    PHASE(PH_PROJ0, phase_proj0(C);)
    PHASE(PH_PREP0, phase_nsa_prep(C);)
    PHASE(PH_CMPH, phase_cmph_xkv(C);)
    PHASE(PH_CMPO, gemm_cmp_h2(C);)
    PHASE(PH_CMPATT, phase_nsa(C);)
    PHASE(PH_SLCWIN, phase_sgu(C);)
    PHASE(PH_OUT0, gemm_f32out(C, WSP(bf16, WS_MIXIN), WSP(bf16, WS_WOUTE), T, 1024, WSP(float, WS_YBUF), 1024);)
    PHASE(PH_LN0, phase_ln(C, INP(float, 0), WSP(float, WS_YBUF), lng + 0 * 1024, lnb + 0 * 1024, XA, XB);)
    PHASE(PH_XQ0, gemm_bf16out(C, XB, WSP(bf16, WS_WXQ), T, 1024, WSP(bf16, WS_XQ), 1024, 0.0625f);)
    PHASE(PH_XS0, gemm_xattn_s(C, 0);)
    PHASE(PH_XO0, gemm_xattn_o(C, 0);)
    PHASE(PH_XW0, gemm_f32out(C, WSP(bf16, WS_XO), WSP(bf16, WS_WXO), T, 1024, WSP(float, WS_YBUF), 1024);)
    PHASE(PH_XLN0, phase_ln(C, XA, WSP(float, WS_YBUF), lng + 1 * 1024, lnb + 1 * 1024, XBF, XB);)
    PHASE(PH_RT0, phase_router(C, 0, XBF);)
    PHASE(PH_SC0, phase_moe_scatter(C, 0);)
    PHASE(PH_GU0, gemm_moe_gu(C, 0);)
    PHASE(PH_DN0, gemm_moe_dn(C, 0);)
    PHASE(PH_CB0, phase_moe_combine_ln(C, 0, XBF, lng + 2 * 1024, lnb + 2 * 1024, XA, XB);)
    PHASE(PH_PROJ1, gemm_bf16out(C, XB, WSP(bf16, WS_WODD), T, ODD_IN, WSP(bf16, R_PROJ), ODD_IN);)
    PHASE(PH_HPREP, phase_hgrn_h1(C); phase_hgrn_conv(C);)
    PHASE(PH_HSCAN, phase_hgrn_h2(C);)
    PHASE(PH_HNORM, phase_hgrn_h3(C);)
    PHASE(PH_OUT1, gemm_f32out(C, WSP(bf16, WS_MIXIN), WSP(bf16, WS_WOUTO), T, 1024, WSP(float, WS_YBUF), 1024);)
    PHASE(PH_LN1, phase_ln(C, XA, WSP(float, WS_YBUF), lng + 3 * 1024, lnb + 3 * 1024, XBF, XB);)
    PHASE(PH_XQ1, gemm_bf16out(C, XB, WSP(bf16, WS_WXQ) + (size_t)1024 * 1024, T, 1024, WSP(bf16, WS_XQ), 1024, 0.0625f);)
    PHASE(PH_XS1, gemm_xattn_s(C, 1);)
    PHASE(PH_XO1, gemm_xattn_o(C, 1);)
    PHASE(PH_XW1, gemm_f32out(C, WSP(bf16, WS_XO), WSP(bf16, WS_WXO) + (size_t)1024 * 1024, T, 1024, WSP(float, WS_YBUF), 1024);)
    PHASE(PH_XLN1, phase_ln(C, XBF, WSP(float, WS_YBUF), lng + 4 * 1024, lnb + 4 * 1024, XA, XB);)
    PHASE(PH_RT1, phase_router(C, 1, XA);)
    PHASE(PH_SC1, phase_moe_scatter(C, 1);)
    PHASE(PH_GU1, gemm_moe_gu(C, 1);)
    PHASE(PH_DN1, gemm_moe_dn(C, 1);)
    PHASE_LAST(PH_CB1, phase_moe_combine_ln(C, 1, XA, lng + 5 * 1024, lnb + 5 * 1024, args.out, XB);)
}

extern "C" void kernel_launch(void* const* d_in, const int* in_sizes, int n_in, void* d_out, int out_size, void* d_ws, size_t ws_size, hipStream_t stream) {
    static int grid = 0;
    if (grid == 0) {
        if (n_in != 29 || ws_size < WS_END) { fprintf(stderr, "kernel_launch: unexpected n_in %d / ws_size %zu (need %zu)\n", n_in, ws_size, (size_t)WS_END); grid = -1; return; }
        int dev = 0, cus = 0, per_cu = 0;
        hipGetDevice(&dev); hipDeviceGetAttribute(&cus, hipDeviceAttributeMultiprocessorCount, dev);
        if (hipFuncSetAttribute((const void*)mega, hipFuncAttributeMaxDynamicSharedMemorySize, LDS_BYTES) != hipSuccess) { fprintf(stderr, "kernel_launch: hipFuncSetAttribute failed\n"); grid = -1; return; }
        hipOccupancyMaxActiveBlocksPerMultiprocessor(&per_cu, (const void*)mega, NTHREADS, LDS_BYTES);
        if (per_cu < 1) fprintf(stderr, "kernel_launch: occupancy query says %d\n", per_cu);
        grid = cus > 0 ? cus : 256;
    }
    if (grid < 0) return;
    hipMemsetAsync((char*)d_ws + WS_CTL, 0, CTL_BYTES, stream);
    Args a{};
    for (int i = 0; i < 29; ++i) a.in[i] = d_in[i];
    a.out = (float*)d_out; a.ws = (unsigned char*)d_ws;
#if ONE_LAUNCH
    a.ph_lo = 0; a.ph_hi = N_PHASES;
    hipLaunchKernelGGL(mega, dim3(grid), dim3(NTHREADS), LDS_BYTES, stream, a);
#else
    for (int p = 0; p < N_PHASES; ++p) { a.ph_lo = p; a.ph_hi = p + 1; hipLaunchKernelGGL(mega, dim3(grid), dim3(NTHREADS), LDS_BYTES, stream, a); }
#endif
}
```
